# Optimizing an MI355X kernel written in HIP

```python
import jax, jax.numpy as jnp
from jax import lax
import numpy as np

D_MODEL = 2048
BATCH = 4
SEQ = 2048
DEPTH = 1

CHUNK = 64
PLE_DIM = 256
LRU_WIDTH = D_MODEL // 2
LRU_HEADS = 16
LRU_HEAD_DIM = LRU_WIDTH // LRU_HEADS
CONV_WIDTH = 4
LRU_C = 8.0
POOL_WIDTH = D_MODEL // 2
POOL_WINDOWS = (2, 4, 8, 16)
POOL_GROUPS = len(POOL_WINDOWS)
POOL_GROUP_DIM = POOL_WIDTH // POOL_GROUPS
N_BRANCHES = 2
IN_COLS = 2 * LRU_WIDTH + POOL_WIDTH + N_BRANCHES * D_MODEL
N_GROUPS = 4
EXPERTS_PER_GROUP = 4
N_EXPERTS = N_GROUPS * EXPERTS_PER_GROUP
TOP_K = 2
D_EXPERT = D_MODEL // 4
EPS = 1e-6

kernel_name = "hybrid_rglru_pool_hmoe_block"


def _rms_norm(x, g):
    xf = x.astype(jnp.float32)
    y = xf * lax.rsqrt(jnp.mean(xf * xf, axis=-1, keepdims=True) + EPS) * g.astype(jnp.float32)
    return y.astype(x.dtype)


def _combine(c1, c2):
    a1, b1 = c1
    a2, b2 = c2
    return a1 * a2, a2 * b1 + b2


def _chunked_linear_scan(a, b):
    bsz, s, c = a.shape
    nc = s // CHUNK
    a_c = a.reshape(bsz, nc, CHUNK, c)
    b_c = b.reshape(bsz, nc, CHUNK, c)
    a_cum, h_loc = lax.associative_scan(_combine, (a_c, b_c), axis=2)

    def step(h_prev, inp):
        acum, hloc = inp
        hs = hloc + acum * h_prev[:, None, :]
        return hs[:, -1], hs

    h0 = jnp.zeros((bsz, c), jnp.float32)
    _, hs = lax.scan(step, h0, (a_cum.transpose(1, 0, 2, 3), h_loc.transpose(1, 0, 2, 3)))
    return hs.transpose(1, 0, 2, 3).reshape(bsz, s, c)


def _rglru_branch(x_rnn, g_rnn, conv_w, conv_b, w_rg_a, b_rg_a, w_rg_x, b_rg_x, lru_lambda):
    dt = x_rnn.dtype
    bsz, s, c = x_rnn.shape
    xc = lax.conv_general_dilated(x_rnn, conv_w, window_strides=(1,), padding=[(CONV_WIDTH - 1, 0)],
                                  dimension_numbers=("NWC", "WIO", "NWC"),
                                  feature_group_count=c) + conv_b
    xh = xc.reshape(bsz, s, LRU_HEADS, LRU_HEAD_DIM)
    r = jax.nn.sigmoid((jnp.einsum("bshi,hij->bshj", xh, w_rg_a) + b_rg_a).astype(jnp.float32))
    ig = jax.nn.sigmoid((jnp.einsum("bshi,hij->bshj", xh, w_rg_x) + b_rg_x).astype(jnp.float32))
    r = r.reshape(bsz, s, c)
    ig = ig.reshape(bsz, s, c)
    log_a = -LRU_C * r * jax.nn.softplus(-lru_lambda.astype(jnp.float32))
    a = jnp.exp(log_a)
    mult = jnp.sqrt(-jnp.expm1(2.0 * log_a))
    h = _chunked_linear_scan(a, mult * ig * xc.astype(jnp.float32))
    return (h * jax.nn.gelu(g_rnn.astype(jnp.float32))).astype(dt)


def _pool_branch(x_pool, w_pool, pool_scale):
    dt = x_pool.dtype
    bsz, s, c = x_pool.shape
    xf = x_pool.astype(jnp.float32)
    cs = jnp.concatenate([jnp.zeros((bsz, 1, c), jnp.float32), jnp.cumsum(xf, axis=1)], axis=1)
    t = jnp.arange(s)
    outs = []
    for g, w in enumerate(POOL_WINDOWS):
        sl = slice(g * POOL_GROUP_DIM, (g + 1) * POOL_GROUP_DIM)
        lo = jnp.maximum(t + 1 - w, 0)
        win_sum = cs[:, 1:, sl] - cs[:, lo, sl]
        cnt = (t + 1 - lo).astype(jnp.float32)[None, :, None]
        outs.append(win_sum / cnt - xf[..., sl])
    d = jnp.stack(outs, axis=2).astype(dt)
    y = jnp.einsum("bsgc,gcd->bsgd", d, w_pool).reshape(bsz, s, c)
    return y * pool_scale


def _mixer(x, norm1_g, w_in, conv_w, conv_b, w_rg_a, b_rg_a, w_rg_x, b_rg_x, lru_lambda,
           w_pool, pool_scale, w_branch_a, w_branch_b, w_out):
    h = _rms_norm(x, norm1_g)
    z = h @ w_in
    o1 = LRU_WIDTH
    o2 = 2 * LRU_WIDTH
    o3 = o2 + POOL_WIDTH
    o4 = o3 + D_MODEL
    x_rnn, g_rnn, x_pool = z[..., :o1], z[..., o1:o2], z[..., o2:o3]
    gate_a, gate_b = z[..., o3:o4], z[..., o4:]
    y_a = _rglru_branch(x_rnn, g_rnn, conv_w, conv_b, w_rg_a, b_rg_a, w_rg_x, b_rg_x, lru_lambda)
    y_b = _pool_branch(x_pool, w_pool, pool_scale)
    u = jax.nn.sigmoid(gate_a) * (y_a @ w_branch_a) + jax.nn.sigmoid(gate_b) * (y_b @ w_branch_b)
    return u @ w_out


def _hier_moe(x, norm2_g, w_router_group, b_router_group, w_router_expert, b_router_expert,
              w_e_gate, w_e_up, w_e_down):
    dt = x.dtype
    bsz, s, d = x.shape
    ht = _rms_norm(x, norm2_g).reshape(bsz * s, d)
    lg = (ht @ w_router_group + b_router_group).astype(jnp.float32)
    pg = jax.nn.softmax(lg, axis=-1)
    g_idx = jnp.argmax(lg, axis=-1)
    g_w = jnp.take_along_axis(pg, g_idx[:, None], axis=1)[:, 0]
    le = (ht @ w_router_expert + b_router_expert).astype(jnp.float32)
    le = le.reshape(-1, N_GROUPS, EXPERTS_PER_GROUP)
    le_sel = jnp.take_along_axis(le, g_idx[:, None, None], axis=1)[:, 0]
    pe = jax.nn.softmax(le_sel, axis=-1)
    top_v, top_i = lax.top_k(pe, TOP_K)
    top_v = top_v / jnp.sum(top_v, axis=-1, keepdims=True)
    e_idx = g_idx[:, None] * EXPERTS_PER_GROUP + top_i
    wts = g_w[:, None] * top_v
    comb = jnp.sum(jax.nn.one_hot(e_idx, N_EXPERTS, dtype=jnp.float32) * wts[..., None], axis=1)
    hg = jnp.einsum("td,edf->tef", ht, w_e_gate)
    hu = jnp.einsum("td,edf->tef", ht, w_e_up)
    act = jax.nn.silu(hg) * hu * comb[:, :, None].astype(dt)
    y = jnp.einsum("tef,efd->td", act, w_e_down)
    return y.reshape(bsz, s, d)


def _per_layer_embed(x, p_i, norm_ple_g, w_ple_gate, w_ple_proj):
    e = p_i.astype(x.dtype) @ w_ple_proj
    g = jax.nn.sigmoid(_rms_norm(x, norm_ple_g) @ w_ple_gate)
    return g * e


def setup_inputs(seed: int = 0) -> dict:
    key = jax.random.key(seed)
    ks = iter(jax.random.split(key, 40))

    def nrm(shape, scale):
        return jax.random.normal(next(ks), shape, jnp.float32) * scale

    a0 = jax.random.uniform(next(ks), (DEPTH, LRU_WIDTH), jnp.float32, minval=0.9, maxval=0.999)
    sa = a0 ** (1.0 / LRU_C)
    lru_lambda = jnp.log(sa) - jnp.log1p(-sa)
    return {
        "x": nrm((BATCH, SEQ, D_MODEL), 1.0),
        "p": nrm((DEPTH, BATCH, SEQ, PLE_DIM), 1.0),
        "norm1_g": 1.0 + nrm((DEPTH, D_MODEL), 0.02),
        "w_in": nrm((DEPTH, D_MODEL, IN_COLS), D_MODEL ** -0.5),
        "conv_w": nrm((DEPTH, CONV_WIDTH, 1, LRU_WIDTH), CONV_WIDTH ** -0.5),
        "conv_b": nrm((DEPTH, LRU_WIDTH), 0.01),
        "w_rg_a": nrm((DEPTH, LRU_HEADS, LRU_HEAD_DIM, LRU_HEAD_DIM), LRU_HEAD_DIM ** -0.5),
        "b_rg_a": nrm((DEPTH, LRU_HEADS, LRU_HEAD_DIM), 0.01),
        "w_rg_x": nrm((DEPTH, LRU_HEADS, LRU_HEAD_DIM, LRU_HEAD_DIM), LRU_HEAD_DIM ** -0.5),
        "b_rg_x": nrm((DEPTH, LRU_HEADS, LRU_HEAD_DIM), 0.01),
        "lru_lambda": lru_lambda,
        "w_pool": nrm((DEPTH, POOL_GROUPS, POOL_GROUP_DIM, POOL_GROUP_DIM), POOL_GROUP_DIM ** -0.5),
        "pool_scale": 1.0 + nrm((DEPTH, POOL_WIDTH), 0.02),
        "w_branch_a": nrm((DEPTH, LRU_WIDTH, D_MODEL), LRU_WIDTH ** -0.5),
        "w_branch_b": nrm((DEPTH, POOL_WIDTH, D_MODEL), POOL_WIDTH ** -0.5),
        "w_out": nrm((DEPTH, D_MODEL, D_MODEL), D_MODEL ** -0.5),
        "norm2_g": 1.0 + nrm((DEPTH, D_MODEL), 0.02),
        "w_router_group": nrm((DEPTH, D_MODEL, N_GROUPS), D_MODEL ** -0.5),
        "b_router_group": nrm((DEPTH, N_GROUPS), 0.01),
        "w_router_expert": nrm((DEPTH, D_MODEL, N_EXPERTS), D_MODEL ** -0.5),
        "b_router_expert": nrm((DEPTH, N_EXPERTS), 0.01),
        "w_e_gate": nrm((DEPTH, N_EXPERTS, D_MODEL, D_EXPERT), D_MODEL ** -0.5),
        "w_e_up": nrm((DEPTH, N_EXPERTS, D_MODEL, D_EXPERT), D_MODEL ** -0.5),
        "w_e_down": nrm((DEPTH, N_EXPERTS, D_EXPERT, D_MODEL), D_EXPERT ** -0.5),
        "norm_ple_g": 1.0 + nrm((DEPTH, D_MODEL), 0.02),
        "w_ple_gate": nrm((DEPTH, D_MODEL, D_MODEL), D_MODEL ** -0.5),
        "w_ple_proj": nrm((DEPTH, PLE_DIM, D_MODEL), PLE_DIM ** -0.5),
        "final_norm_g": 1.0 + nrm((D_MODEL,), 0.02),
    }


def reference(x, p, norm1_g, w_in, conv_w, conv_b, w_rg_a, b_rg_a, w_rg_x, b_rg_x, lru_lambda,
              w_pool, pool_scale, w_branch_a, w_branch_b, w_out, norm2_g, w_router_group,
              b_router_group, w_router_expert, b_router_expert, w_e_gate, w_e_up, w_e_down,
              norm_ple_g, w_ple_gate, w_ple_proj, final_norm_g):
    for i in range(DEPTH):
        x = x + _mixer(x, norm1_g[i], w_in[i], conv_w[i], conv_b[i], w_rg_a[i], b_rg_a[i],
                       w_rg_x[i], b_rg_x[i], lru_lambda[i], w_pool[i], pool_scale[i],
                       w_branch_a[i], w_branch_b[i], w_out[i])
        x = x + _hier_moe(x, norm2_g[i], w_router_group[i], b_router_group[i], w_router_expert[i],
                          b_router_expert[i], w_e_gate[i], w_e_up[i], w_e_down[i])
        x = x + _per_layer_embed(x, p[i], norm_ple_g[i], w_ple_gate[i], w_ple_proj[i])
    return _rms_norm(x, final_norm_g)
```

```cpp
#include <hip/hip_runtime.h>
#include <cstdio>
#include <cstdint>

#ifndef MK_N_LAUNCHES
#define MK_N_LAUNCHES 1
#endif

#define LAS __attribute__((address_space(3)))
#define GAS __attribute__((address_space(1)))
typedef unsigned short bf16;
typedef short bf16x8 __attribute__((ext_vector_type(8)));
typedef float f32x4 __attribute__((ext_vector_type(4)));
typedef float f32x2 __attribute__((ext_vector_type(2)));
typedef unsigned u32x4 __attribute__((ext_vector_type(4)));
typedef unsigned u32x2 __attribute__((ext_vector_type(2)));

constexpr int D = 2048, BATCH = 4, SEQ = 2048, T = BATCH * SEQ;
constexpr int PLE = 256, LRU_W = 1024, HD = 64, POOL_W = 1024, PGD = 256;
constexpr int IN_COLS = 7168, NE = 16, DE = 512;
constexpr float EPS = 1e-6f;
constexpr int NWAVES = 8, NTHREADS = 512;

constexpr size_t MiB = 1u << 20;
constexpr size_t WS_CTL = 0, CTL_ZERO_BYTES = 1 * MiB;
constexpr size_t WS_WIN = 1 * MiB;
constexpr size_t WS_WA = 29 * MiB;
constexpr size_t WS_WB = 33 * MiB;
constexpr size_t WS_W2 = 37 * MiB;
constexpr size_t WS_WOUT = 41 * MiB;
constexpr size_t WS_WPG = 49 * MiB;
constexpr size_t WS_WPP = 57 * MiB;
constexpr size_t WS_WPS = 58 * MiB;
constexpr size_t WS_MISC = 59 * MiB;
constexpr size_t WS_WGU = 60 * MiB;
constexpr size_t WS_WD = 124 * MiB;
constexpr size_t WS_XN = 156 * MiB;
constexpr size_t WS_Z = 188 * MiB;
constexpr size_t WS_YS = 188 * MiB;
constexpr size_t WS_ACT = 252 * MiB;
constexpr size_t WS_E = 272 * MiB;
constexpr size_t WS_YD = 300 * MiB;
constexpr size_t WS_PB = 332 * MiB;
constexpr size_t WS_LISTS = 336 * MiB;
constexpr size_t WS_END = 337 * MiB;
constexpr size_t MI_WRT = 524288  ;
constexpr size_t MI_RSTD2 = 0, MI_RSTDP = 32768, MI_CST = 65536  , MI_WRG = 131072  ;
constexpr size_t WS_LIST = WS_LISTS, WS_WL = WS_LISTS + 524288;
constexpr int CW_BAR = 4096;
constexpr int CW_CNT = 64;
constexpr size_t CTL_GRAN = 262144;

constexpr int RING_BYTES = 131072;
constexpr int LDSCTL_OFF = RING_BYTES, MISC_OFF = LDSCTL_OFF + 320;
constexpr int TBL_OFF = MISC_OFF + 256;
constexpr int LDS_BYTES = 147456;

#define RLX_AGENT __ATOMIC_RELAXED, __HIP_MEMORY_SCOPE_AGENT
#define LDS_WAIT() asm volatile("s_waitcnt lgkmcnt(0)" ::: "memory")
__device__ __forceinline__ unsigned f2bf(float f) { unsigned u = __builtin_bit_cast(unsigned, f); return (u + 0x7fffu + ((u >> 16) & 1u)) >> 16; }
__device__ __forceinline__ unsigned pk2(float lo, float hi) { return f2bf(lo) | (f2bf(hi) << 16); }
__device__ __forceinline__ float bf2f(unsigned b) { return __builtin_bit_cast(float, b << 16); }
__device__ __forceinline__ float bflo(unsigned w) { return __builtin_bit_cast(float, w << 16); }
__device__ __forceinline__ float bfhi(unsigned w) { return __builtin_bit_cast(float, w & 0xffff0000u); }
__device__ __forceinline__ float wave_sum(float v) {
#pragma unroll
    for (int o = 1; o < 64; o <<= 1) v += __shfl_xor(v, o);
    return v;
}
__device__ __forceinline__ float fsigmoid(float v) { return __builtin_amdgcn_rcpf(1.f + __expf(-v)); }
__device__ __forceinline__ float gelu_tanh(float v) { const float u = 1.5957691216057308f * (v + 0.044715f * v * v * v); return v * fsigmoid(u); }

__device__ __forceinline__ const void* ld_ptr(LAS unsigned char* lds, int k) {
    const volatile LAS unsigned* p = (const volatile LAS unsigned*)(lds + TBL_OFF) + 2 * k;
    const unsigned lo = __builtin_amdgcn_readfirstlane(p[0]), hi = __builtin_amdgcn_readfirstlane(p[1]);
    return (const void*)(((unsigned long long)hi << 32) | lo);
}
#define INP(k) ((const float*)ld_ptr(F.lds, (k)))
#define OUTP ((float*)ld_ptr(F.lds, 28))
#define WSP ((unsigned char*)ld_ptr(F.lds, 29))

namespace g8 {
constexpr int BM = 256, BK = 64, HALF = 128, HTB = HALF * BK * 2, NXCD = 8, WGM = 8;
__host__ __device__ __forceinline__ int lds_byte(int r, int c) { const int st = (r >> 4) * 2 + (c >> 5), rr = r & 15, cc = c & 31, ob = rr * 64 + cc * 2; return st * 1024 + (ob ^ (((ob >> 9) & 1) << 5)); }
__host__ __device__ __forceinline__ void stage_rc(int b, int& R, int& C) { const int st = b / 1024, sb = b % 1024, swz = sb ^ (((sb >> 9) & 1) << 5); R = (st >> 1) * 16 + swz / 64; C = (st & 1) * 32 + (swz % 64) / 2; }
__host__ __device__ __forceinline__ int perm32(int rho) { const int n = rho >> 4, i = rho & 15; return 8 * (i >> 2) + 4 * n + (i & 3); }

struct GU {
    const char* A; const char* B;
    const int* gl; int gn;
    unsigned lda, ldb;
    int nt;
    int pm, pn, aux;
};
__device__ __forceinline__ void tile_of(int L, int nM, int nN, int& pm, int& pn) {
    const int nwg = nM * nN; int wgid = L; { const int q = nwg / NXCD, r = nwg % NXCD, xcd = wgid % NXCD, off = wgid / NXCD; wgid = (xcd < r ? xcd * (q + 1) : r * (q + 1) + (xcd - r) * q) + off; }
    const int nig = WGM * nN, gid = wgid / nig, fm = gid * WGM, gsz = (nM - fm) < WGM ? (nM - fm) : WGM;
    pm = fm + ((wgid % nig) % gsz); pn = (wgid % nig) / gsz;
}
__device__ __forceinline__ unsigned cvt_pk_bf16(float lo, float hi) { unsigned r; asm volatile("v_cvt_pk_bf16_f32 %0, %1, %2" : "=v"(r) : "v"(lo), "v"(hi)); return r; }

__device__ __forceinline__ void glds16(const char* sbase, unsigned voff, unsigned lds_dst) {
    unsigned keep;
    asm volatile("s_mov_b32 %0, m0\n\ts_mov_b32 m0, %3\n\ts_nop 0\n\tglobal_load_lds_dwordx4 %1, %2\n\ts_mov_b32 m0, %0" : "=&s"(keep) : "v"(voff), "s"(sbase), "s"(lds_dst) : "memory");
}
template <bool GATHER, class Epi, class Sched>
__device__ __forceinline__ void gemm_phase(LAS unsigned char* lds, int wave, const Sched& S, const Epi& E) {
    const int wid = wave, lane = (int)__builtin_amdgcn_mbcnt_hi(~0u, __builtin_amdgcn_mbcnt_lo(~0u, 0u)), tid = wid * 64 + lane;
    const int wr = wid >> 2, wc = wid & 3, fr = lane & 15, fq = lane >> 4;
    int sR[2], sRp[2], sC[2];
#pragma unroll
    for (int i = 0; i < 2; ++i) { stage_rc(tid * 16 + i * 8192, sR[i], sC[i]); sRp[i] = (sR[i] & ~31) + perm32(sR[i] & 31); }
    const unsigned ldsw = (unsigned)wid * 1024u, ldsb = (unsigned)(uintptr_t)lds;
    const int aoff = lds_byte(wr * 64 + fr, fq * 8), boff = lds_byte(wc * 32 + fr, fq * 8);
#define G8_OFFS(u, vA, vB) do { _Pragma("unroll") for (int _h = 0; _h < (GATHER ? 2 : 1); ++_h) _Pragma("unroll") for (int _i = 0; _i < 2; ++_i) { const int _r = _h * HALF + sR[_i]; int _row = _r; \
            if (GATHER) { _row = 0; if (_r < (u).gn) _row = (u).gl[_r] >> 1; } vA[_h][_i] = (unsigned)_row * (u).lda + (unsigned)sC[_i] * 2u; } \
        _Pragma("unroll") for (int _i = 0; _i < 2; ++_i) vB[_i] = (unsigned)sRp[_i] * (u).ldb + (unsigned)sC[_i] * 2u; } while (0)
#define G8_SA(b, h) (((b) * 2 + (h)) * HTB)
#define G8_SB(b, h) ((4 + (b) * 2 + (h)) * HTB)
#define G8_STAGE(bufoff, gbase, voff) do { _Pragma("unroll") for (int _i = 0; _i < 2; ++_i) \
        glds16((const char*)(gbase), (voff)[_i], ldsb + (unsigned)(bufoff) + ldsw + (unsigned)(_i * 8192)); } while (0)
#define G8_LDA(dst, b, h) do { _Pragma("unroll") for (int m = 0; m < 4; ++m) _Pragma("unroll") for (int k = 0; k < 2; ++k) dst[m][k] = *(const LAS bf16x8*)(lds + G8_SA(b, h) + aoff + m * 2048 + k * 1024); } while (0)
#define G8_LDB(dst, b, h) do { _Pragma("unroll") for (int n = 0; n < 2; ++n) _Pragma("unroll") for (int k = 0; k < 2; ++k) dst[n][k] = *(const LAS bf16x8*)(lds + G8_SB(b, h) + boff + n * 2048 + k * 1024); } while (0)
#define G8_MMA(ai, bj, At, Bt) do { __builtin_amdgcn_s_setprio(1); _Pragma("unroll") for (int m = 0; m < 4; ++m) _Pragma("unroll") for (int n = 0; n < 2; ++n) _Pragma("unroll") for (int k = 0; k < 2; ++k) \
        acc[ai][bj][m][n] = __builtin_amdgcn_mfma_f32_16x16x32_bf16(Bt[n][k], At[m][k], acc[ai][bj][m][n], 0, 0, 0); __builtin_amdgcn_s_setprio(0); } while (0)
#define G8_WAIT_V(n) asm volatile("s_waitcnt vmcnt(" #n ")" ::: "memory")
#define G8_WAIT_L(n) asm volatile("s_waitcnt lgkmcnt(" #n ")" ::: "memory")
#define G8_BAR __builtin_amdgcn_s_barrier()
#define G8_SCHED __builtin_amdgcn_sched_barrier(0)
    GU cur, nxt; int ui = 0;
    if (!S.next(0, cur)) return;
    f32x4 acc[2][2][4][2];
#pragma unroll
    for (int a = 0; a < 2; ++a)
#pragma unroll
        for (int b = 0; b < 2; ++b)
#pragma unroll
            for (int m = 0; m < 4; ++m)
#pragma unroll
                for (int n = 0; n < 2; ++n) acc[a][b][m][n] = (f32x4){0.f, 0.f, 0.f, 0.f};
    bf16x8 At[4][2], B0[2][2], B1[2][2];
    unsigned vA[2][2], vB[2], wA[2][2], wB[2];
    G8_OFFS(cur, vA, vB);
    const char* cA = cur.A; const char* cB = cur.B; unsigned chB = HALF * cur.ldb, chA = GATHER ? 0u : HALF * cur.lda;
    {
        G8_STAGE(G8_SB(0, 0), cB, vB); G8_STAGE(G8_SB(0, 1), cB + chB, vB); G8_STAGE(G8_SA(0, 0), cA, vA[0]); G8_STAGE(G8_SA(0, 1), cA + chA, vA[GATHER ? 1 : 0]);
        if (wr == 1) G8_BAR;
        G8_WAIT_V(2); G8_BAR;
        G8_STAGE(G8_SB(1, 0), cB + 128, vB); G8_STAGE(G8_SA(1, 0), cA + 128, vA[0]); G8_STAGE(G8_SB(1, 1), cB + chB + 128, vB);
        G8_WAIT_V(6); G8_BAR;
    }
    for (;;) {
        const bool has_next = S.next(ui + 1, nxt);
        int nt = __builtin_amdgcn_readfirstlane(cur.nt); asm volatile("" : "+s"(nt));
        for (int t = 0; t < nt; t += 2) {
            const bool last = (t == nt - 2);
            const char* a1 = cA + (size_t)(t + 1) * 128;
            const char* a2; const char* b2; unsigned xhB, xhA;
            if (last) {
                if (has_next) { G8_OFFS(nxt, wA, wB); a2 = nxt.A; b2 = nxt.B; xhB = HALF * nxt.ldb; xhA = GATHER ? 0u : HALF * nxt.lda; }
                else { _Pragma("unroll") for (int h = 0; h < (GATHER ? 2 : 1); ++h) _Pragma("unroll") for (int i = 0; i < 2; ++i) wA[h][i] = vA[h][i]; wB[0] = vB[0]; wB[1] = vB[1]; a2 = cA; b2 = cB; xhB = chB; xhA = chA; }
            } else {
                _Pragma("unroll") for (int h = 0; h < (GATHER ? 2 : 1); ++h) _Pragma("unroll") for (int i = 0; i < 2; ++i) wA[h][i] = vA[h][i]; wB[0] = vB[0]; wB[1] = vB[1];
                a2 = cA + (size_t)(t + 2) * 128; b2 = cB + (size_t)(t + 2) * 128; xhB = chB; xhA = chA;
            }
            const char* a3 = a2 + 128; const char* b3 = b2 + 128;
            G8_LDB(B0, 0, 0); G8_LDB(B1, 0, 1); G8_SCHED; G8_LDA(At, 0, 0); G8_STAGE(G8_SA(1, 1), a1 + chA, vA[GATHER ? 1 : 0]);
            G8_WAIT_V(8); G8_WAIT_L(0); G8_BAR; G8_MMA(0, 0, At, B0); G8_MMA(0, 1, At, B1); G8_BAR; G8_SCHED;
            G8_LDA(At, 0, 1); G8_STAGE(G8_SB(0, 0), b2, wB); G8_STAGE(G8_SB(0, 1), b2 + xhB, wB); G8_STAGE(G8_SA(0, 0), a2, wA[0]);
            G8_WAIT_V(8); G8_WAIT_L(0); G8_BAR; G8_MMA(1, 0, At, B0); G8_MMA(1, 1, At, B1); G8_BAR; G8_SCHED;
            G8_LDB(B0, 1, 0); G8_LDB(B1, 1, 1); G8_SCHED; G8_LDA(At, 1, 0); G8_STAGE(G8_SA(0, 1), a2 + xhA, wA[GATHER ? 1 : 0]);
            G8_WAIT_V(8); G8_WAIT_L(0); G8_BAR; G8_MMA(0, 0, At, B0); G8_MMA(0, 1, At, B1); G8_BAR; G8_SCHED;
            G8_LDA(At, 1, 1); G8_STAGE(G8_SB(1, 0), b3, wB); G8_STAGE(G8_SB(1, 1), b3 + xhB, wB); G8_STAGE(G8_SA(1, 0), a3, wA[0]);
            G8_WAIT_V(8); G8_WAIT_L(0); G8_BAR; G8_MMA(1, 0, At, B0); G8_MMA(1, 1, At, B1); G8_BAR; G8_SCHED;
        }
        if (wr == 0) G8_BAR;
        E(acc, cur, wr, wc, fr, fq);
        if (!has_next) break;
#pragma unroll
        for (int a = 0; a < 2; ++a)
#pragma unroll
            for (int b = 0; b < 2; ++b)
#pragma unroll
                for (int m = 0; m < 4; ++m)
#pragma unroll
                    for (int n = 0; n < 2; ++n) acc[a][b][m][n] = (f32x4){0.f, 0.f, 0.f, 0.f};
        cur = nxt; cA = cur.A; cB = cur.B; chB = HALF * cur.ldb; chA = GATHER ? 0u : HALF * cur.lda; ++ui;
#pragma unroll
        for (int h = 0; h < (GATHER ? 2 : 1); ++h)
#pragma unroll
            for (int i = 0; i < 2; ++i) vA[h][i] = wA[h][i];
        vB[0] = wB[0]; vB[1] = wB[1];
        if (wr == 1) G8_BAR;
    }
    G8_WAIT_V(0);
    G8_BAR;
#undef G8_OFFS
#undef G8_SA
#undef G8_SB
#undef G8_STAGE
#undef G8_LDA
#undef G8_LDB
#undef G8_MMA
#undef G8_WAIT_V
#undef G8_WAIT_L
#undef G8_BAR
#undef G8_SCHED
}
}
using g8::GU;

#define XB_TMO      128
#define XB_XCNT(j)  (256  + 64 * (j))
#define XB_XSUB(j)  (1280 + 64 * (j))
#define XB_XGEN(j)  (2304 + 64 * (j))
#define XB_TOP      3328
#define XB_TOPGEN   3392
#define XCD_BAR_WORDS 3456
#define XB_SPIN_CAP (1u << 18)
__device__ __forceinline__ unsigned xb_ld(unsigned* p)              { return __hip_atomic_load(p, __ATOMIC_RELAXED, __HIP_MEMORY_SCOPE_AGENT); }
__device__ __forceinline__ unsigned xb_add(unsigned* p, unsigned v) { return __hip_atomic_fetch_add(p, v, __ATOMIC_RELAXED, __HIP_MEMORY_SCOPE_AGENT); }
__device__ __forceinline__ unsigned xb_xcc_id() { return (unsigned)__builtin_amdgcn_s_getreg((3 << 11) | 20) & 0xFu; }
#define XB_SPIN(cond, bar) do { unsigned _sp = 0; while (cond) { __builtin_amdgcn_s_sleep(1); \
    if ((++_sp & 255u) == 0u) { if (xb_ld(&(bar)[XB_TMO])) break; if (_sp > XB_SPIN_CAP) { atomicAdd(&(bar)[XB_TMO], 1u); break; } } } } while (0)
struct XcdBarrier { unsigned* bar; unsigned x; volatile LAS unsigned* st; };
__device__ __forceinline__ XcdBarrier xcd_barrier_post(unsigned* bar, volatile LAS unsigned* st) {
    XcdBarrier b; b.bar = bar; b.x = xb_xcc_id(); b.st = st;
    if (threadIdx.x == 0) (void)xb_add(&bar[XB_XCNT(b.x)], 1u);
    return b;
}
__device__ __forceinline__ void xcd_barrier_complete(unsigned* bar, unsigned x, unsigned& nloc, unsigned& nx) {
    const unsigned G = gridDim.x * gridDim.y * gridDim.z;
    unsigned sum, cnt, mine, sp = 0u;
    for (;;) {
        sum = 0u; cnt = 0u; mine = 0u;
#pragma unroll
        for (unsigned j = 0; j < 16; ++j) { const unsigned c = xb_ld(&bar[XB_XCNT(j)]); sum += c; cnt += (c > 0u) ? 1u : 0u; mine = (j == x) ? c : mine; }
        if (sum == G) break;
        __builtin_amdgcn_s_sleep(1);
        if ((++sp & 255u) == 0u) { if (xb_ld(&bar[XB_TMO])) break; if (sp > XB_SPIN_CAP) { atomicAdd(&bar[XB_TMO], 1u); break; } }
    }
    nloc = mine > 0u ? mine : 1u; nx = cnt > 0u ? cnt : 1u;
}
__device__ __forceinline__ void xcd_barrier(const XcdBarrier& b) {
    asm volatile("s_waitcnt vmcnt(0)" ::: "memory");
    __syncthreads();
    if (threadIdx.x == 0) {
        unsigned* bar = b.bar;
        __builtin_amdgcn_s_waitcnt(0);
        unsigned nloc = b.st[0], nx = b.st[1];
        if (nloc == 0u) { xcd_barrier_complete(bar, b.x, nloc, nx); b.st[0] = nloc; b.st[1] = nx; }
        const unsigned old = xb_add(&bar[XB_XSUB(b.x)], 1u);
        const unsigned gen = old / nloc;
        if (old + 1u == (gen + 1u) * nloc) {
            __builtin_amdgcn_fence(__ATOMIC_RELEASE, "agent");
            asm volatile("s_waitcnt vmcnt(0)" ::: "memory");
            const unsigned og = xb_add(&bar[XB_TOP], 1u);
            const unsigned tg = og / nx;
            if (og + 1u == (tg + 1u) * nx) xb_add(&bar[XB_TOPGEN], 1u);
            else XB_SPIN(xb_ld(&bar[XB_TOPGEN]) == tg, bar);
            __builtin_amdgcn_fence(__ATOMIC_ACQUIRE, "agent");
            xb_add(&bar[XB_XGEN(b.x)], 1u);
            asm volatile("s_waitcnt vmcnt(0)" ::: "memory");
        } else {
            XB_SPIN(xb_ld(&bar[XB_XGEN(b.x)]) == gen, bar);
            __builtin_amdgcn_fence(__ATOMIC_ACQUIRE, "agent");
            asm volatile("s_waitcnt vmcnt(0)" ::: "memory");
        }
    }
    __syncthreads();
}

struct Args { const float* in[28]; float* out; unsigned char* ws; int ph_lo, ph_hi; };
struct Frame {
    LAS unsigned char* lds; volatile LAS unsigned* MISC;
    int tid, lane, wave, vcu, G;
};

struct TItem { const float* src; bf16* dst; const float* ks; int ldw, ldt; };
constexpr int TI_IN = (D / 64) * (IN_COLS / 32), TI_A = (LRU_W / 64) * (D / 32), TI_O = (D / 64) * (D / 32), TI_PP = (PLE / 64) * (D / 32), TI_EG = (D / 64) * (DE / 32), TI_ED = (DE / 64) * (D / 32);
constexpr int TI_EARLY = TI_IN + TI_A + 2 * NE * TI_EG;
constexpr int TI_MID = TI_EARLY + TI_A + 2 * TI_O + TI_PP;
constexpr int TI_ALL = TI_MID + NE * TI_ED;
__device__ __forceinline__ bool p0_decode(Frame& F, unsigned char* ws, int it, int it_end, TItem& t) {
    constexpr int I_IN = (D / 64) * (IN_COLS / 32), I_A = (LRU_W / 64) * (D / 32), I_O = (D / 64) * (D / 32), I_PP = (PLE / 64) * (D / 32);
    constexpr int I_EG = (D / 64) * (DE / 32), I_ED = (DE / 64) * (D / 32);
    constexpr int NITEMS = I_IN + 2 * I_A + 2 * I_O + I_PP + 2 * NE * I_EG + NE * I_ED;
    if (it >= it_end) return false;
    int r = it; const float* W; bf16* WT; int ldw, ldt, kb, n0, drow0; const float* ks = nullptr;
    if (r < I_IN) { const int nb = IN_COLS / 32; W = INP(3); ldw = IN_COLS; kb = r / nb; n0 = 32 * (r % nb); WT = (bf16*)(ws + WS_WIN); ldt = D; drow0 = n0; }
    else if ((r -= I_IN) < I_A) { const int nb = D / 32; W = INP(14); ldw = D; kb = r / nb; n0 = 32 * (r % nb); WT = (bf16*)(ws + WS_WB); ldt = POOL_W; drow0 = n0; }
    else if ((r -= I_A) < 2 * NE * I_EG) {
        const int up = r / (NE * I_EG); r -= up * NE * I_EG; const int e = r / I_EG; r -= e * I_EG; const int nb = DE / 32; kb = r / nb; n0 = 32 * (r % nb);
        W = (up ? INP(22) : INP(21)) + (size_t)e * D * DE; ldw = DE; WT = (bf16*)(ws + WS_WGU); ldt = D; drow0 = e * 1024 + (n0 / 128) * 256 + up * 128 + (n0 % 128); ks = INP(16); }
    else if ((r -= 2 * NE * I_EG) < I_A) { const int nb = D / 32; W = INP(13); ldw = D; kb = r / nb; n0 = 32 * (r % nb); WT = (bf16*)(ws + WS_WA); ldt = LRU_W; drow0 = n0; }
    else if ((r -= I_A) < I_O) { const int nb = D / 32; W = INP(15); ldw = D; kb = r / nb; n0 = 32 * (r % nb); WT = (bf16*)(ws + WS_WOUT); ldt = D; drow0 = n0; }
    else if ((r -= I_O) < I_O) { const int nb = D / 32; W = INP(25); ldw = D; kb = r / nb; n0 = 32 * (r % nb); WT = (bf16*)(ws + WS_WPG); ldt = D; drow0 = n0; ks = INP(24); }
    else if ((r -= I_O) < I_PP) { const int nb = D / 32; W = INP(26); ldw = D; kb = r / nb; n0 = 32 * (r % nb); WT = (bf16*)(ws + WS_WPP); ldt = PLE; drow0 = n0; }
    else { r -= I_PP; const int e = r / I_ED; r -= e * I_ED; const int nb = D / 32; kb = r / nb; n0 = 32 * (r % nb);
        W = INP(23) + (size_t)e * DE * D; ldw = D; WT = (bf16*)(ws + WS_WD); ldt = DE; drow0 = e * D + n0; }
    t.src = W + (size_t)(64 * kb) * ldw + n0; t.dst = WT + (size_t)drow0 * ldt + 64 * kb; t.ks = ks ? ks + 64 * kb : nullptr; t.ldw = ldw; t.ldt = ldt; return true;
}
__device__ __forceinline__ void p0_load(const TItem& t, float (&v)[32], int lane) {
    const float* p = t.src + (size_t)(lane >> 5) * t.ldw + (lane & 31);
#pragma unroll
    for (int i = 0; i < 32; ++i) v[i] = p[(size_t)(2 * i) * t.ldw];
}
__device__ __forceinline__ void p0_store(const TItem& t, const float (&v)[32], LAS float* scr, int lane) {
    if (t.ks) {
#pragma unroll
        for (int i = 0; i < 32; ++i) scr[(2 * i + (lane >> 5)) * 33 + (lane & 31)] = v[i] * t.ks[2 * i + (lane >> 5)];
    } else {
#pragma unroll
        for (int i = 0; i < 32; ++i) scr[(2 * i + (lane >> 5)) * 33 + (lane & 31)] = v[i];
    }
    LDS_WAIT(); asm volatile("" ::: "memory");
    const int c = lane & 7;
#pragma unroll
    for (int j = 0; j < 4; ++j) { const int n = (lane >> 3) + 8 * j; const LAS float* s = scr + (8 * c) * 33 + n;
        u32x4 o; o.x = pk2(s[0 * 33], s[1 * 33]); o.y = pk2(s[2 * 33], s[3 * 33]); o.z = pk2(s[4 * 33], s[5 * 33]); o.w = pk2(s[6 * 33], s[7 * 33]);
        *(u32x4*)(t.dst + (size_t)n * t.ldt + 8 * c) = o; }
    LDS_WAIT(); asm volatile("" ::: "memory");
}
__device__ __forceinline__ void p0_transposes(Frame& F, unsigned char* ws, int it0, int it1, int wk, int nwk) {
    LAS float* scr = (LAS float*)(F.lds + F.wave * 16384);
    TItem ta, tb; float va[32], vb[32]; int it = it0 + wk;
    bool ha = p0_decode(F, ws, it, it1, ta); if (ha) p0_load(ta, va, F.lane);
    while (ha) {
        const bool hb = p0_decode(F, ws, it + nwk, it1, tb); if (hb) p0_load(tb, vb, F.lane);
        p0_store(ta, va, scr, F.lane);
        if (!hb) break;
        it += 2 * nwk; ha = p0_decode(F, ws, it, it1, ta); if (ha) p0_load(ta, va, F.lane);
        p0_store(tb, vb, scr, F.lane);
    }
}
__device__ __forceinline__ void p0_prologue(Frame& F) {
    LAS float* scr = (LAS float*)(F.lds + F.wave * 16384);
    const int gw = F.vcu * NWAVES + F.wave, NGW = F.G * NWAVES;
    unsigned char* ws = WSP;
    p0_transposes(F, ws, 0, TI_EARLY, gw, NGW);
    const size_t gt = (size_t)(F.vcu * NTHREADS + F.tid), NGT = (size_t)F.G * NTHREADS;
    for (size_t i = gt; i < (size_t)4 * PGD * PGD / 4; i += NGT) { const f32x4 v = ((const f32x4*)INP(11))[i]; const int g = (int)(i / (PGD * PGD / 4)), d0 = (int)((i * 4) % PGD); const float* sc = INP(12) + g * PGD + d0;
        u32x2 o; o.x = pk2(v.x * sc[0], v.y * sc[1]); o.y = pk2(v.z * sc[2], v.w * sc[3]); ((u32x2*)(ws + WS_WPS))[i] = o; }
    for (size_t i = gt; i < (size_t)T * PLE / 4; i += NGT) { const f32x4 v = ((const f32x4*)INP(1))[i]; u32x2 o; o.x = pk2(v.x, v.y); o.y = pk2(v.z, v.w); ((u32x2*)(ws + WS_PB))[i] = o; }
    for (size_t i = gt; i < (size_t)16 * 8 * 64; i += NGT) { const int h = (int)(i >> 9), row = (int)(i >> 6) & 7, j = (int)i & 63, c = h * 64 + j; float v;
        if (row < 4) v = INP(4)[row * LRU_W + c]; else if (row == 4) v = INP(5)[c]; else if (row == 5) v = INP(7)[c]; else if (row == 6) v = INP(9)[c]; else v = 8.0f * log1pf(expf(-INP(10)[c]));
        ((float*)(ws + WS_MISC + MI_CST))[i] = v; }
    for (size_t i = gt; i < (size_t)16 * 24 * 64; i += NGT) { const int h = (int)(i / (24 * 64)), fi = (int)(i / 64) % 24, ln = (int)i & 63, nt = fi >> 1, sx = fi & 1, fr_ = ln & 15, fq_ = ln >> 4;
        float v[8];
#pragma unroll
        for (int j = 0; j < 8; ++j) { const int k = 32 * sx + 8 * fq_ + j;
            if (nt < 4) v[j] = INP(6)[(h * 64 + k) * 64 + 16 * nt + fr_]; else if (nt < 8) v[j] = INP(8)[(h * 64 + k) * 64 + 16 * (nt - 4) + fr_]; else v[j] = (k == 16 * (nt - 8) + fr_) ? 1.0f : 0.0f; }
        u32x4 o; o.x = pk2(v[0], v[1]); o.y = pk2(v[2], v[3]); o.z = pk2(v[4], v[5]); o.w = pk2(v[6], v[7]); ((u32x4*)(ws + WS_MISC + MI_WRG))[i] = o; }
    for (size_t i = gt; i < (size_t)64 * 2 * 64; i += NGT) { const int ks = (int)(i >> 7), nt = (int)(i >> 6) & 1, ln = (int)i & 63, fr_ = ln & 15, fq_ = ln >> 4, n = 16 * nt + fr_;
        float hi[8], lo[8];
#pragma unroll
        for (int j = 0; j < 8; ++j) { const int k = 32 * ks + 8 * fq_ + j; float v = 0.f; if (n < 4) v = INP(17)[k * 4 + n]; else if (n < 20) v = INP(19)[k * 16 + (n - 4)];
            v *= INP(16)[k]; hi[j] = bf2f(f2bf(v)); lo[j] = v - hi[j]; }
        u32x4 oh, ol; oh.x = pk2(hi[0], hi[1]); oh.y = pk2(hi[2], hi[3]); oh.z = pk2(hi[4], hi[5]); oh.w = pk2(hi[6], hi[7]); ol.x = pk2(lo[0], lo[1]); ol.y = pk2(lo[2], lo[3]); ol.z = pk2(lo[4], lo[5]); ol.w = pk2(lo[6], lo[7]);
        u32x4* dst = (u32x4*)(ws + WS_MISC + MI_WRT) + ((size_t)(ks * 2 + nt) * 2) * 64 + ln; dst[0] = oh; dst[64] = ol; }
    for (int m = gw; m < T; m += NGW) {
        const f32x4* xr = (const f32x4*)(INP(0) + (size_t)m * D) + F.lane; const f32x4* gr = (const f32x4*)INP(2) + F.lane;
        f32x4 v[8]; float s = 0.f;
#pragma unroll
        for (int j = 0; j < 8; ++j) { v[j] = xr[64 * j]; s += (v[j].x * v[j].x + v[j].y * v[j].y) + (v[j].z * v[j].z + v[j].w * v[j].w); }
        const float rstd = 1.f / sqrtf(wave_sum(s) * (1.f / D) + EPS);
        u32x2* o8 = (u32x2*)(ws + WS_XN + (size_t)m * D * 2) + F.lane;
#pragma unroll
        for (int j = 0; j < 8; ++j) { const f32x4 g = gr[64 * j]; u32x2 o; o.x = pk2(v[j].x * rstd * g.x, v[j].y * rstd * g.y); o.y = pk2(v[j].z * rstd * g.z, v[j].w * rstd * g.w); o8[64 * j] = o; }
    }
}

struct SchedDense {
    const char* A; const char* B; unsigned lda, ldb; int nt, nM, nN, G, c;
    __device__ __forceinline__ bool next(int i, GU& u) const {
        const int L = i * G + c; if (L >= nM * nN) return false;
        g8::tile_of(L, nM, nN, u.pm, u.pn);
        u.A = A + (size_t)u.pm * 256 * lda; u.B = B + (size_t)u.pn * 256 * ldb; u.gl = nullptr; u.gn = 0; u.lda = lda; u.ldb = ldb; u.nt = nt; u.aux = 0; return true;
    }
};
struct SchedP1 {
    const char* XN; const char* WIN; const char* WBt; const char* WPS; int G, c;
    __device__ __forceinline__ bool next(int i, GU& u) const {
        const int L = __builtin_amdgcn_readfirstlane(i * G + c); if (L >= 896 + 32) return false;
        u.gl = nullptr; u.gn = 0;
        if (L < 896) { g8::tile_of(L, 32, 28, u.pm, u.pn); u.A = XN + (size_t)u.pm * 256 * 4096; u.B = WIN + (size_t)u.pn * 256 * 4096; u.lda = 4096; u.ldb = 4096; u.nt = 32; u.aux = 0; return true; }
        const int J = L - 896, g = J >> 3; u.pm = J & 7; u.pn = 0; u.aux = 256 * g;
        u.A = WBt + (size_t)u.pm * 256 * 2048 + (size_t)g * 512; u.B = WPS + (size_t)g * PGD * PGD * 2; u.lda = 2048; u.ldb = 512; u.nt = 4; return true;
    }
};
struct SchedW2 {
    const char* WBt; const char* WPS; int G, c;
    __device__ __forceinline__ bool next(int i, GU& u) const {
        const int L = i * G + c; if (L >= 32) return false;
        const int g = L >> 3; u.pm = L & 7; u.pn = 0; u.aux = 256 * g;
        u.A = WBt + (size_t)u.pm * 256 * 2048 + (size_t)g * 512; u.B = WPS + (size_t)g * PGD * PGD * 2; u.gl = nullptr; u.gn = 0; u.lda = 2048; u.ldb = 512; u.nt = 4; return true;
    }
};
struct SchedU {
    const char* YD; const char* WA; const char* W2; int G, c;
    __device__ __forceinline__ bool next(int i, GU& u) const {
        const int L = (i >> 1) * G + c; if (L >= 256) return false;
        const int src = i & 1; g8::tile_of(L, 32, 8, u.pm, u.pn);
        u.A = YD + (size_t)u.pm * 256 * 4096 + src * 2048; u.B = (src ? W2 : WA) + (size_t)u.pn * 256 * 2048; u.gl = nullptr; u.gn = 0; u.lda = 4096; u.ldb = 2048; u.nt = 16; u.aux = src; return true;
    }
};
struct SchedMoeUp {
    const char* X; const char* W; const int* list; const int* cnt; const volatile LAS int* ts; int G, c;
    __device__ __forceinline__ bool next(int i, GU& u) const {
        const int L = i * G + c; const int ntile = __builtin_amdgcn_readfirstlane(ts[16]); if (L >= 4 * ntile) return false;
        const int rt = L >> 2, pn = L & 3; int e = 0;
#pragma unroll
        for (int j = 1; j < 16; ++j) e += (rt >= ts[j]) ? 1 : 0;
        e = __builtin_amdgcn_readfirstlane(e);
        const int i0 = __builtin_amdgcn_readfirstlane(rt - ts[e]); int gn = __builtin_amdgcn_readfirstlane(cnt[e]) - 256 * i0; gn = gn > 256 ? 256 : gn;
        u.A = X; u.gl = list + e * T + 256 * i0; u.gn = gn; u.lda = 4096; u.B = W + ((size_t)e * 1024 + 256 * pn) * 4096; u.ldb = 4096; u.nt = 32; u.pm = rt; u.pn = pn; u.aux = e; return true;
    }
};
struct SchedE {
    const char* PB; const char* WPP; int first, nfree, rank;
    __device__ __forceinline__ bool next(int i, GU& u) const {
        if (rank < 0) return false; const int L = rank + i * nfree; if (L >= 256) return false;
        g8::tile_of(L, 32, 8, u.pm, u.pn); u.A = PB + (size_t)u.pm * 256 * 512; u.B = WPP + (size_t)u.pn * 256 * 512; u.gl = nullptr; u.gn = 0; u.lda = 512; u.ldb = 512; u.nt = 4; u.aux = 0; return true;
    }
};
struct SchedMoeDown {
    const char* ACT; const char* W; const int* list; const int* cnt; const volatile LAS int* ts; int G, c;
    __device__ __forceinline__ bool next(int i, GU& u) const {
        const int L = i * G + c; const int ntile = __builtin_amdgcn_readfirstlane(ts[16]); if (L >= 8 * ntile) return false;
        const int rt = L >> 3, pn = L & 7; int e = 0;
#pragma unroll
        for (int j = 1; j < 16; ++j) e += (rt >= ts[j]) ? 1 : 0;
        e = __builtin_amdgcn_readfirstlane(e);
        const int i0 = __builtin_amdgcn_readfirstlane(rt - ts[e]); int gn = __builtin_amdgcn_readfirstlane(cnt[e]) - 256 * i0; gn = gn > 256 ? 256 : gn;
        u.A = ACT + (size_t)rt * 256 * 1024; u.gl = nullptr; u.gn = gn; u.lda = 1024; u.B = W + ((size_t)e * 2048 + 256 * pn) * 1024; u.ldb = 1024; u.nt = 8; u.pm = rt; u.pn = pn; u.aux = e * T + 256 * i0; return true;
    }
};

#define EPI_ROWS_BEGIN  _Pragma("unroll") for (int ai = 0; ai < 2; ++ai) _Pragma("unroll") for (int m = 0; m < 4; ++m) { const int r = ai * 128 + wr * 64 + m * 16 + fr;
#define EPI_ROWS_END    asm volatile("" ::: "memory"); }
struct EpiPlain {
    bf16* O; int ldc;
    __device__ __forceinline__ void operator()(const f32x4 (&acc)[2][2][4][2], const GU& u, int wr, int wc, int fr, int fq) const {
        const int col0 = u.pn * 256 + u.aux + wc * 32 + 8 * fq;
        EPI_ROWS_BEGIN
            bf16* rowp = O + (size_t)(u.pm * 256 + r) * ldc + col0;
#pragma unroll
            for (int bj = 0; bj < 2; ++bj) { const f32x4 v0 = acc[ai][bj][m][0], v1 = acc[ai][bj][m][1];
                u32x4 w; w.x = g8::cvt_pk_bf16(v0[0], v0[1]); w.y = g8::cvt_pk_bf16(v0[2], v0[3]); w.z = g8::cvt_pk_bf16(v1[0], v1[1]); w.w = g8::cvt_pk_bf16(v1[2], v1[3]);
                *(u32x4*)(rowp + bj * 128) = w; }
        EPI_ROWS_END
    }
};
struct EpiZ {
    bf16* Z;
    __device__ __forceinline__ void operator()(const f32x4 (&acc)[2][2][4][2], const GU& u, int wr, int wc, int fr, int fq) const {
        const int col0 = u.pn * 256 + wc * 32 + 8 * fq; const int kind = (u.pn >= 12) ? 2 : ((u.pn >= 4 && u.pn < 8) ? 1 : 0);
        EPI_ROWS_BEGIN
            bf16* rowp = Z + (size_t)(u.pm * 256 + r) * IN_COLS + col0;
#pragma unroll
            for (int bj = 0; bj < 2; ++bj) { f32x4 v0 = acc[ai][bj][m][0], v1 = acc[ai][bj][m][1];
                if (kind == 1) {
#pragma unroll
                    for (int j = 0; j < 4; ++j) { v0[j] = gelu_tanh(v0[j]); v1[j] = gelu_tanh(v1[j]); } }
                else if (kind == 2) {
#pragma unroll
                    for (int j = 0; j < 4; ++j) { v0[j] = fsigmoid(v0[j]); v1[j] = fsigmoid(v1[j]); } }
                u32x4 w; w.x = g8::cvt_pk_bf16(v0[0], v0[1]); w.y = g8::cvt_pk_bf16(v0[2], v0[3]); w.z = g8::cvt_pk_bf16(v1[0], v1[1]); w.w = g8::cvt_pk_bf16(v1[2], v1[3]);
                *(u32x4*)(rowp + bj * 128) = w; }
        EPI_ROWS_END
    }
};
struct EpiP1 { EpiZ z; EpiPlain w2;
    __device__ __forceinline__ void operator()(const f32x4 (&acc)[2][2][4][2], const GU& u, int wr, int wc, int fr, int fq) const { if (u.nt == 4) w2(acc, u, wr, wc, fr, fq); else z(acc, u, wr, wc, fr, fq); }
};
__device__ __forceinline__ void unpack8(const u32x4 w, float (&f)[8]) { f[0] = bflo(w.x); f[1] = bfhi(w.x); f[2] = bflo(w.y); f[3] = bfhi(w.y); f[4] = bflo(w.z); f[5] = bfhi(w.z); f[6] = bflo(w.w); f[7] = bfhi(w.w); }
struct EpiU {
    bf16* U; const bf16* Z;
    __device__ __forceinline__ void operator()(const f32x4 (&acc)[2][2][4][2], const GU& u, int wr, int wc, int fr, int fq) const {
        const int col0 = u.pn * 256 + wc * 32 + 8 * fq; const int gcol = (u.aux ? 5120 : 3072) + col0;
        EPI_ROWS_BEGIN
            const size_t row = (size_t)(u.pm * 256 + r);
#pragma unroll
            for (int bj = 0; bj < 2; ++bj) {
                float g[8], p[8]; unpack8(*(const u32x4*)(Z + row * IN_COLS + gcol + bj * 128), g);
                const f32x4 v0 = acc[ai][bj][m][0], v1 = acc[ai][bj][m][1];
                float o[8];
#pragma unroll
                for (int j = 0; j < 4; ++j) { o[j] = v0[j] * g[j]; o[4 + j] = v1[j] * g[4 + j]; }
                bf16* up = U + row * D + col0 + bj * 128;
                if (u.aux) { unpack8(*(const u32x4*)up, p);
#pragma unroll
                    for (int j = 0; j < 8; ++j) o[j] += p[j]; }
                u32x4 w; w.x = g8::cvt_pk_bf16(o[0], o[1]); w.y = g8::cvt_pk_bf16(o[2], o[3]); w.z = g8::cvt_pk_bf16(o[4], o[5]); w.w = g8::cvt_pk_bf16(o[6], o[7]);
                *(u32x4*)up = w; }
        EPI_ROWS_END
    }
};
struct EpiX1 {
    const float* x; bf16* X1B;
    __device__ __forceinline__ void operator()(const f32x4 (&acc)[2][2][4][2], const GU& u, int wr, int wc, int fr, int fq) const {
        const int col0 = u.pn * 256 + wc * 32 + 8 * fq;
        EPI_ROWS_BEGIN
            const size_t off = (size_t)(u.pm * 256 + r) * D + col0;
#pragma unroll
            for (int bj = 0; bj < 2; ++bj) {
                const f32x4 a0 = *(const f32x4*)(x + off + bj * 128), a1 = *(const f32x4*)(x + off + bj * 128 + 4);
                const f32x4 v0 = acc[ai][bj][m][0] + a0, v1 = acc[ai][bj][m][1] + a1;
                u32x4 w; w.x = g8::cvt_pk_bf16(v0[0], v0[1]); w.y = g8::cvt_pk_bf16(v0[2], v0[3]); w.z = g8::cvt_pk_bf16(v1[0], v1[1]); w.w = g8::cvt_pk_bf16(v1[2], v1[3]);
                *(u32x4*)(X1B + off + bj * 128) = w; }
        EPI_ROWS_END
    }
};
struct EpiAct {
    bf16* ACT; const float* rstd2;
    __device__ __forceinline__ void operator()(const f32x4 (&acc)[2][2][4][2], const GU& u, int wr, int wc, int fr, int fq) const {
        const int col0 = u.pn * 128 + wc * 32 + 8 * fq;
        EPI_ROWS_BEGIN
            int tok = 0; if (r < u.gn) tok = u.gl[r] >> 1;
            const float rs = rstd2[tok];
            const f32x4 g0 = acc[ai][0][m][0] * rs, g1 = acc[ai][0][m][1] * rs, u0 = acc[ai][1][m][0] * rs, u1 = acc[ai][1][m][1] * rs;
            float o[8];
#pragma unroll
            for (int j = 0; j < 4; ++j) { o[j] = g0[j] * fsigmoid(g0[j]) * u0[j]; o[4 + j] = g1[j] * fsigmoid(g1[j]) * u1[j]; }
            u32x4 w; w.x = g8::cvt_pk_bf16(o[0], o[1]); w.y = g8::cvt_pk_bf16(o[2], o[3]); w.z = g8::cvt_pk_bf16(o[4], o[5]); w.w = g8::cvt_pk_bf16(o[6], o[7]);
            *(u32x4*)(ACT + (size_t)(u.pm * 256 + r) * DE + col0) = w;
        EPI_ROWS_END
    }
};
struct EpiDown {
    bf16* YS; const int* list; const float* wl;
    __device__ __forceinline__ void operator()(const f32x4 (&acc)[2][2][4][2], const GU& u, int wr, int wc, int fr, int fq) const {
        const int col0 = u.pn * 256 + wc * 32 + 8 * fq;
        EPI_ROWS_BEGIN
            if (r < u.gn) {
                const int ent = list[u.aux + r]; const float w8 = wl[u.aux + r];
                bf16* rowp = YS + ((size_t)(ent & 1) * T + (size_t)(ent >> 1)) * D + col0;
#pragma unroll
                for (int bj = 0; bj < 2; ++bj) { const f32x4 v0 = acc[ai][bj][m][0] * w8, v1 = acc[ai][bj][m][1] * w8;
                    u32x4 w; w.x = g8::cvt_pk_bf16(v0[0], v0[1]); w.y = g8::cvt_pk_bf16(v0[2], v0[3]); w.z = g8::cvt_pk_bf16(v1[0], v1[1]); w.w = g8::cvt_pk_bf16(v1[2], v1[3]);
                    *(u32x4*)(rowp + bj * 128) = w; }
            }
        EPI_ROWS_END
    }
};
struct EpiPle {
    float* X3; const bf16* X2B; const bf16* E; const float* rstdp;
    __device__ __forceinline__ void operator()(const f32x4 (&acc)[2][2][4][2], const GU& u, int wr, int wc, int fr, int fq) const {
        const int col0 = u.pn * 256 + wc * 32 + 8 * fq;
        EPI_ROWS_BEGIN
            const size_t row = (size_t)(u.pm * 256 + r), off = row * D + col0; const float rs = rstdp[row];
#pragma unroll
            for (int bj = 0; bj < 2; ++bj) {
                float x2[8], e[8]; unpack8(*(const u32x4*)(X2B + off + bj * 128), x2); unpack8(*(const u32x4*)(E + off + bj * 128), e);
                const f32x4 v0 = acc[ai][bj][m][0] * rs, v1 = acc[ai][bj][m][1] * rs; f32x4 o0, o1;
#pragma unroll
                for (int j = 0; j < 4; ++j) { o0[j] = x2[j] + fsigmoid(v0[j]) * e[j]; o1[j] = x2[4 + j] + fsigmoid(v1[j]) * e[4 + j]; }
                *(f32x4*)(X3 + off + bj * 128) = o0; *(f32x4*)(X3 + off + bj * 128 + 4) = o1; }
        EPI_ROWS_END
    }
};

constexpr int P2_BFR = 0, P2_CST = 24576, P2_WT = 26624, P2_HS = 30720, P2_IO = 32768, P2_IOW = 9216, P2_ROW = 144;
__device__ __forceinline__ float neg_expm1(float x) {
    const float p = x * (1.0f + x * (0.5f + x * (0.16666667f + x * (0.041666668f + x * (0.0083333338f + x * 0.0013888889f)))));
    const float q = 1.0f - __expf(x);
    return (x > -0.25f) ? -p : q;
}
__device__ __forceinline__ void p2_lru_item(Frame& F, unsigned char* ws, int item) {
    const bf16* Z = (const bf16*)(ws + WS_Z); bf16* YD = (bf16*)(ws + WS_YD);
    const int lane = F.lane, wave = F.wave, tid = F.tid, fr = lane & 15, fq = lane >> 4;
    const int c = item >> 6, bh = item & 63, b = bh >> 4, h = bh & 15;
    const int tw = b * SEQ + c * 256 + 32 * wave, sw = c * 256 + 32 * wave;
    LAS unsigned char* L = F.lds;
    __syncthreads();
    {
        const u32x4* src = (const u32x4*)(ws + WS_MISC + MI_WRG) + (size_t)h * 24 * 64;
#pragma unroll
        for (int k = 0; k < 3; ++k) *(LAS u32x4*)(L + P2_BFR + (tid + 512 * k) * 16) = src[tid + 512 * k];
        if (tid < 128) *(LAS u32x4*)(L + P2_CST + tid * 16) = ((const u32x4*)(ws + WS_MISC + MI_CST) + (size_t)h * 128)[tid];
    }
    LAS unsigned char* GG = L + P2_IO + wave * P2_IOW; LAS unsigned char* YT = GG + 32 * P2_ROW;
#pragma unroll
    for (int k = 0; k < 4; ++k) { const int p = lane + 64 * k, row = p >> 3, c8 = p & 7;
        *(LAS u32x4*)(GG + row * P2_ROW + c8 * 16) = *(const u32x4*)(Z + (size_t)(tw + row) * IN_COLS + 1024 + 64 * h + 8 * c8); }
    __syncthreads();
    const LAS float* CS = (const LAS float*)(L + P2_CST);
    float ba4[4], bx4[4], sp4[4];
#pragma unroll
    for (int n = 0; n < 4; ++n) { ba4[n] = CS[5 * 64 + 16 * n + fr]; bx4[n] = CS[6 * 64 + 16 * n + fr]; sp4[n] = CS[7 * 64 + 16 * n + fr]; }
    float cA[4] = {1.f, 1.f, 1.f, 1.f}, cH[4] = {0.f, 0.f, 0.f, 0.f};
    float Ac[2][4][4], Hl[2][4][4];
#pragma unroll
    for (int rt = 0; rt < 2; ++rt) {
        bf16x8 af[2];
#pragma unroll
        for (int sx = 0; sx < 2; ++sx) {
            const int k0 = 32 * sx + 8 * fq; float xa[8];
            { const f32x4 c0 = *(const LAS f32x4*)(CS + 4 * 64 + k0), c1 = *(const LAS f32x4*)(CS + 4 * 64 + k0 + 4);
#pragma unroll
              for (int j = 0; j < 4; ++j) { xa[j] = c0[j]; xa[4 + j] = c1[j]; } }
#pragma unroll
            for (int q = 0; q < 4; ++q) {
                const int dpos = 16 * rt + fr + q - 3; const bool ok = (sw + dpos) >= 0; const int drow = ok ? dpos : 0;
                float xv[8]; unpack8(*(const u32x4*)(Z + (size_t)(tw + drow) * IN_COLS + 64 * h + k0), xv);
                const f32x4 w0 = *(const LAS f32x4*)(CS + q * 64 + k0), w1 = *(const LAS f32x4*)(CS + q * 64 + k0 + 4); const float mk = ok ? 1.f : 0.f;
#pragma unroll
                for (int j = 0; j < 4; ++j) { xa[j] += w0[j] * (xv[j] * mk); xa[4 + j] += w1[j] * (xv[4 + j] * mk); }
            }
            u32x4 pk; pk.x = pk2(xa[0], xa[1]); pk.y = pk2(xa[2], xa[3]); pk.z = pk2(xa[4], xa[5]); pk.w = pk2(xa[6], xa[7]);
            af[sx] = __builtin_bit_cast(bf16x8, pk);
            __builtin_amdgcn_sched_barrier(0);
        }
        __builtin_amdgcn_sched_barrier(0);
#pragma unroll
        for (int n = 0; n < 4; ++n) {
            f32x4 Dm[3];
#pragma unroll
            for (int q = 0; q < 3; ++q) { Dm[q] = (f32x4){0.f, 0.f, 0.f, 0.f};
#pragma unroll
                for (int sx = 0; sx < 2; ++sx) { const bf16x8 bfr = *(const LAS bf16x8*)(L + P2_BFR + ((4 * q + n) * 2 + sx) * 1024 + lane * 16); Dm[q] = __builtin_amdgcn_mfma_f32_16x16x32_bf16(af[sx], bfr, Dm[q], 0, 0, 0); } }
            float a[4], hh[4];
#pragma unroll
            for (int i = 0; i < 4; ++i) {
                const float r = fsigmoid(Dm[0][i] + ba4[n]), ig = fsigmoid(Dm[1][i] + bx4[n]), xv = Dm[2][i];
                const float la = -r * sp4[n];
                a[i] = __expf(la); hh[i] = sqrtf(neg_expm1(2.0f * la)) * ig * xv;
            }
#pragma unroll
            for (int i = 1; i < 4; ++i) { hh[i] = a[i] * hh[i - 1] + hh[i]; a[i] = a[i] * a[i - 1]; }
            float XA = a[3], XH = hh[3];
            { const float pa = __shfl_up(XA, 16), ph = __shfl_up(XH, 16); if (fq >= 1) { XH = XA * ph + XH; XA = XA * pa; } }
            { const float pa = __shfl_up(XA, 32), ph = __shfl_up(XH, 32); if (fq >= 2) { XH = XA * ph + XH; XA = XA * pa; } }
            float EA = __shfl_up(XA, 16), EH = __shfl_up(XH, 16); if (fq == 0) { EA = 1.f; EH = 0.f; }
            const float TA = __shfl(XA, 48 + fr), TH = __shfl(XH, 48 + fr);
            const float PA = cA[n] * EA, PH = EA * cH[n] + EH;
#pragma unroll
            for (int i = 0; i < 4; ++i) { Ac[rt][n][i] = PA * a[i]; Hl[rt][n][i] = a[i] * PH + hh[i]; }
            cH[n] = TA * cH[n] + TH; cA[n] = cA[n] * TA;
            __builtin_amdgcn_sched_barrier(0);
        }
    }
    if (fq == 0) {
#pragma unroll
        for (int n = 0; n < 4; ++n) *(LAS f32x2*)(L + P2_WT + (wave * 64 + 16 * n + fr) * 8) = (f32x2){cA[n], cH[n]};
    }
    __syncthreads();
    if (wave == 0) {
        unsigned long long* GR = (unsigned long long*)(ws + WS_CTL + CTL_GRAN);
        float hin = 0.f;
        if (c > 0) {
            unsigned long long* g = GR + ((size_t)(bh * 8 + c - 1) * 64 + lane); unsigned sp = 0; unsigned long long v;
            for (;;) { v = __hip_atomic_load(g, RLX_AGENT); if (__all((unsigned)(v >> 32) == 1u)) break; __builtin_amdgcn_s_sleep(1); if (++sp > (1u << 22)) break; }
            hin = __builtin_bit_cast(float, (unsigned)v);
        }
        float hcur = hin;
#pragma unroll
        for (int w = 0; w < 8; ++w) { *(LAS float*)(L + P2_HS + (w * 64 + lane) * 4) = hcur; const f32x2 t = *(const LAS f32x2*)(L + P2_WT + (w * 64 + lane) * 8); hcur = t.x * hcur + t.y; }
        __hip_atomic_store(GR + ((size_t)(bh * 8 + c) * 64 + lane), (1ull << 32) | (unsigned long long)__builtin_bit_cast(unsigned, hcur), RLX_AGENT);
    }
    __syncthreads();
    float hs[4];
#pragma unroll
    for (int n = 0; n < 4; ++n) hs[n] = *(const LAS float*)(L + P2_HS + (wave * 64 + 16 * n + fr) * 4);
#pragma unroll
    for (int rt = 0; rt < 2; ++rt)
#pragma unroll
        for (int n = 0; n < 4; ++n)
#pragma unroll
            for (int i = 0; i < 4; ++i) { const int row = 16 * rt + 4 * fq + i, col = 16 * n + fr;
                const float g = bf2f(*(const LAS unsigned short*)(GG + row * P2_ROW + col * 2));
                *(LAS unsigned short*)(YT + row * P2_ROW + col * 2) = (unsigned short)f2bf((Hl[rt][n][i] + Ac[rt][n][i] * hs[n]) * g); }
    LDS_WAIT();
#pragma unroll
    for (int k = 0; k < 4; ++k) { const int p = lane + 64 * k, row = p >> 3, c8 = p & 7;
        *(u32x4*)(YD + (size_t)(tw + row) * D + 64 * h + 8 * c8) = *(const LAS u32x4*)(YT + row * P2_ROW + c8 * 16); }
}
__device__ __forceinline__ void p2_pool_item(Frame& F, unsigned char* ws, int blk) {
    const bf16* Z = (const bf16*)(ws + WS_Z); bf16* YD = (bf16*)(ws + WS_YD);
    const int tid = F.tid, g = (2 * tid) >> 8, w = 2 << g, tb = blk * 64, s0p = tb % SEQ;
    const unsigned* zc = (const unsigned*)(Z + 2048 + 2 * tid);
    float s0 = 0.f, s1 = 0.f;
    for (int k = 1; k <= w; ++k) if (s0p - k >= 0) { const unsigned v = zc[(size_t)(tb - k) * (IN_COLS / 2)]; s0 += bflo(v); s1 += bfhi(v); }
    for (int tt = 0; tt < 64; ++tt) {
        const unsigned v = zc[(size_t)(tb + tt) * (IN_COLS / 2)]; const float x0 = bflo(v), x1 = bfhi(v); s0 += x0; s1 += x1;
        const int pos = s0p + tt; if (pos - w >= 0) { const unsigned vo = zc[(size_t)(tb + tt - w) * (IN_COLS / 2)]; s0 -= bflo(vo); s1 -= bfhi(vo); }
        const float inv = 1.0f / (float)((pos + 1) < w ? (pos + 1) : w);
        *(unsigned*)(YD + (size_t)(tb + tt) * D + 1024 + 2 * tid) = pk2(s0 * inv - x0, s1 * inv - x1);
    }
}
__device__ __forceinline__ void p2_fast(Frame& F) {
    unsigned char* ws = WSP;
    for (int item = (int)blockIdx.x; item < 512 + 128; item += F.G) { if (item < 512) p2_lru_item(F, ws, item); else p2_pool_item(F, ws, item - 512); }
}

__device__ __forceinline__ void p5_router(Frame& F) {
    unsigned char* ws = WSP; const float* X1 = OUTP; const float* g2 = INP(16); const float* wg = INP(17); const float* bg = INP(18); const float* we = INP(19); const float* be = INP(20);
    float* rstd2 = (float*)(ws + WS_MISC + MI_RSTD2); int* list = (int*)(ws + WS_LIST); float* wl = (float*)(ws + WS_WL); unsigned* cnt = (unsigned*)(ws + WS_CTL) + CW_CNT;
    const int gw = F.vcu * NWAVES + F.wave, NGW = F.G * NWAVES;
    for (int t = gw; t < T; t += NGW) {
        const f32x4* xr = (const f32x4*)(X1 + (size_t)t * D) + F.lane; const f32x4* gr = (const f32x4*)g2 + F.lane;
        f32x4 v[8]; float s = 0.f;
#pragma unroll
        for (int j = 0; j < 8; ++j) { v[j] = xr[64 * j]; s += (v[j].x * v[j].x + v[j].y * v[j].y) + (v[j].z * v[j].z + v[j].w * v[j].w); }
        const float rstd = 1.f / sqrtf(wave_sum(s) * (1.f / D) + EPS);
        float lg[4] = {0.f, 0.f, 0.f, 0.f}, le[16];
#pragma unroll
        for (int j = 0; j < 16; ++j) le[j] = 0.f;
#pragma unroll
        for (int j = 0; j < 8; ++j) { const f32x4 g = gr[64 * j]; const int k0 = 4 * (F.lane + 64 * j);
#pragma unroll
            for (int q = 0; q < 4; ++q) { const float hv = v[j][q] * rstd * g[q]; const f32x4 w4 = *(const f32x4*)(wg + (size_t)(k0 + q) * 4);
#pragma unroll
                for (int c = 0; c < 4; ++c) lg[c] += hv * w4[c];
#pragma unroll
                for (int c4 = 0; c4 < 4; ++c4) { const f32x4 w16 = *(const f32x4*)(we + (size_t)(k0 + q) * 16 + 4 * c4);
#pragma unroll
                    for (int c = 0; c < 4; ++c) le[4 * c4 + c] += hv * w16[c]; } } }
#pragma unroll
        for (int j = 0; j < 4; ++j) lg[j] = wave_sum(lg[j]) + bg[j];
#pragma unroll
        for (int j = 0; j < 16; ++j) le[j] = wave_sum(le[j]) + be[j];
        if (F.lane == 0) {
            int gi = 0; float gm = lg[0];
#pragma unroll
            for (int j = 1; j < 4; ++j) if (lg[j] > gm) { gm = lg[j]; gi = j; }
            float gs = 0.f;
#pragma unroll
            for (int j = 0; j < 4; ++j) gs += expf(lg[j] - gm);
            const float g_w = 1.f / gs;
            float ls[4];
#pragma unroll
            for (int j = 0; j < 4; ++j) { float vv = le[j];
#pragma unroll
                for (int g = 1; g < 4; ++g) if (gi == g) vv = le[g * 4 + j];
                ls[j] = vv; }
            float mx = ls[0];
#pragma unroll
            for (int j = 1; j < 4; ++j) mx = fmaxf(mx, ls[j]);
            float pe[4], ps = 0.f;
#pragma unroll
            for (int j = 0; j < 4; ++j) { pe[j] = expf(ls[j] - mx); ps += pe[j]; }
#pragma unroll
            for (int j = 0; j < 4; ++j) pe[j] /= ps;
            float v0 = -1.f; int i0 = 0;
#pragma unroll
            for (int j = 0; j < 4; ++j) if (pe[j] > v0) { v0 = pe[j]; i0 = j; }
            float v1 = -1.f; int i1 = 0;
#pragma unroll
            for (int j = 0; j < 4; ++j) if (j != i0 && pe[j] > v1) { v1 = pe[j]; i1 = j; }
            const float sv = v0 + v1; const int e0 = gi * 4 + i0, e1 = gi * 4 + i1;
            rstd2[t] = rstd;
            const unsigned p0 = __hip_atomic_fetch_add(cnt + e0, 1u, RLX_AGENT), p1 = __hip_atomic_fetch_add(cnt + e1, 1u, RLX_AGENT);
            list[e0 * T + p0] = t * 2; wl[e0 * T + p0] = g_w * v0 / sv; list[e1 * T + p1] = t * 2 + 1; wl[e1 * T + p1] = g_w * v1 / sv;
        }
    }
}

constexpr int P5_PL = 0, P5_SS = 32768, P5_LG = 36864, P5_RS = 40960;
__device__ __forceinline__ void p5_fast(Frame& F) {
    unsigned char* ws = WSP; const bf16* X1B = (const bf16*)(ws + WS_YD); const float* bg = INP(18); const float* be = INP(20);
    float* rstd2 = (float*)(ws + WS_MISC + MI_RSTD2); int* list = (int*)(ws + WS_LIST); float* wl = (float*)(ws + WS_WL); unsigned* cnt = (unsigned*)(ws + WS_CTL) + CW_CNT;
    const u32x4* WRT = (const u32x4*)(ws + WS_MISC + MI_WRT);
    const int lane = F.lane, wave = F.wave, tid = F.tid, fr = lane & 15, fq = lane >> 4; LAS unsigned char* L = F.lds;
    for (int item = (int)blockIdx.x; item < T / 32; item += F.G) {
        const int r0 = item * 32;
        f32x4 acc[2][2]; float ss[2] = {0.f, 0.f};
#pragma unroll
        for (int rt = 0; rt < 2; ++rt)
#pragma unroll
            for (int nt = 0; nt < 2; ++nt) acc[rt][nt] = (f32x4){0.f, 0.f, 0.f, 0.f};
#pragma unroll 2
        for (int kk = 0; kk < 8; ++kk) {
            const int ks = wave * 8 + kk;
            bf16x8 bh[2], bl[2];
#pragma unroll
            for (int nt = 0; nt < 2; ++nt) { const u32x4* p = WRT + ((size_t)(ks * 2 + nt) * 2) * 64 + lane; bh[nt] = __builtin_bit_cast(bf16x8, p[0]); bl[nt] = __builtin_bit_cast(bf16x8, p[64]); }
#pragma unroll
            for (int rt = 0; rt < 2; ++rt) {
                const u32x4 xw = *(const u32x4*)(X1B + (size_t)(r0 + 16 * rt + fr) * D + 32 * ks + 8 * fq);
                float v[8]; unpack8(xw, v);
#pragma unroll
                for (int j = 0; j < 8; ++j) ss[rt] += v[j] * v[j];
                const bf16x8 ah = __builtin_bit_cast(bf16x8, xw);
#pragma unroll
                for (int nt = 0; nt < 2; ++nt) {
                    acc[rt][nt] = __builtin_amdgcn_mfma_f32_16x16x32_bf16(ah, bh[nt], acc[rt][nt], 0, 0, 0);
                    acc[rt][nt] = __builtin_amdgcn_mfma_f32_16x16x32_bf16(ah, bl[nt], acc[rt][nt], 0, 0, 0);
                }
            }
        }
        __syncthreads();
#pragma unroll
        for (int rt = 0; rt < 2; ++rt) {
#pragma unroll
            for (int nt = 0; nt < 2; ++nt)
#pragma unroll
                for (int i = 0; i < 4; ++i) *(LAS float*)(L + P5_PL + ((wave * 32 + 16 * rt + 4 * fq + i) * 32 + 16 * nt + fr) * 4) = acc[rt][nt][i];
            float s = ss[rt]; s += __shfl_xor(s, 16); s += __shfl_xor(s, 32);
            if (fq == 0) *(LAS float*)(L + P5_SS + (wave * 32 + 16 * rt + fr) * 4) = s;
        }
        __syncthreads();
        {
            const int row = tid >> 4, col = tid & 15; float a0 = 0.f, a1 = 0.f;
#pragma unroll
            for (int w = 0; w < 8; ++w) { a0 += *(const LAS float*)(L + P5_PL + ((w * 32 + row) * 32 + col) * 4); a1 += *(const LAS float*)(L + P5_PL + ((w * 32 + row) * 32 + col + 16) * 4); }
            *(LAS float*)(L + P5_LG + (row * 32 + col) * 4) = a0; *(LAS float*)(L + P5_LG + (row * 32 + col + 16) * 4) = a1;
            if (col == 0) { float s = 0.f;
#pragma unroll
                for (int w = 0; w < 8; ++w) s += *(const LAS float*)(L + P5_SS + (w * 32 + row) * 4);
                *(LAS float*)(L + P5_RS + row * 4) = 1.f / sqrtf(s * (1.f / D) + EPS); }
        }
        __syncthreads();
        if (tid < 32) {
            const int t = r0 + tid; const float rstd = *(const LAS float*)(L + P5_RS + tid * 4); const LAS float* lgp = (const LAS float*)(L + P5_LG + tid * 128);
            float lg[4], le[16];
#pragma unroll
            for (int j = 0; j < 4; ++j) lg[j] = lgp[j] * rstd + bg[j];
#pragma unroll
            for (int j = 0; j < 16; ++j) le[j] = lgp[4 + j] * rstd + be[j];
            int gi = 0; float gm = lg[0];
#pragma unroll
            for (int j = 1; j < 4; ++j) if (lg[j] > gm) { gm = lg[j]; gi = j; }
            float gs = 0.f;
#pragma unroll
            for (int j = 0; j < 4; ++j) gs += expf(lg[j] - gm);
            const float g_w = 1.f / gs;
            float ls[4];
#pragma unroll
            for (int j = 0; j < 4; ++j) { float vv = le[j];
#pragma unroll
                for (int g = 1; g < 4; ++g) if (gi == g) vv = le[g * 4 + j];
                ls[j] = vv; }
            float mx = ls[0];
#pragma unroll
            for (int j = 1; j < 4; ++j) mx = fmaxf(mx, ls[j]);
            float pe[4], ps = 0.f;
#pragma unroll
            for (int j = 0; j < 4; ++j) { pe[j] = expf(ls[j] - mx); ps += pe[j]; }
#pragma unroll
            for (int j = 0; j < 4; ++j) pe[j] /= ps;
            float v0 = -1.f; int i0 = 0;
#pragma unroll
            for (int j = 0; j < 4; ++j) if (pe[j] > v0) { v0 = pe[j]; i0 = j; }
            float v1 = -1.f; int i1 = 0;
#pragma unroll
            for (int j = 0; j < 4; ++j) if (j != i0 && pe[j] > v1) { v1 = pe[j]; i1 = j; }
            const float sv = v0 + v1; const int e0 = gi * 4 + i0, e1 = gi * 4 + i1;
            rstd2[t] = rstd;
            const unsigned p0 = __hip_atomic_fetch_add(cnt + e0, 1u, RLX_AGENT), p1 = __hip_atomic_fetch_add(cnt + e1, 1u, RLX_AGENT);
            list[e0 * T + p0] = t * 2; wl[e0 * T + p0] = g_w * v0 / sv; list[e1 * T + p1] = t * 2 + 1; wl[e1 * T + p1] = g_w * v1 / sv;
        }
    }
}
__device__ __forceinline__ void moe_table(Frame& F, volatile LAS int* ts) {
    if (F.tid == 0) { unsigned* ctl = (unsigned*)(WSP + WS_CTL); int s = 0; for (int e = 0; e < NE; ++e) { ts[e] = s; s += ((int)__hip_atomic_load(ctl + CW_CNT + e, RLX_AGENT) + 255) >> 8; } ts[16] = s; }
    __syncthreads();
}
__device__ __forceinline__ void p8_combine(Frame& F) {
    unsigned char* ws = WSP; const bf16* YS = (const bf16*)(ws + WS_YS); bf16* XB = (bf16*)(ws + WS_YD); float* rstdp = (float*)(ws + WS_MISC + MI_RSTDP);
    const int gw = F.vcu * NWAVES + F.wave, NGW = F.G * NWAVES;
    for (int t = gw; t < T; t += NGW) {
        u32x4* xr = (u32x4*)(XB + (size_t)t * D) + F.lane; const u32x4* y0 = (const u32x4*)(YS + (size_t)t * D) + F.lane; const u32x4* y1 = (const u32x4*)(YS + (size_t)(T + t) * D) + F.lane;
        float s = 0.f;
#pragma unroll
        for (int j = 0; j < 4; ++j) { float a[8], b[8], c[8]; unpack8(xr[64 * j], a); unpack8(y0[64 * j], b); unpack8(y1[64 * j], c);
#pragma unroll
            for (int q = 0; q < 8; ++q) { a[q] += b[q] + c[q]; a[q] = bf2f(f2bf(a[q])); s += a[q] * a[q]; }
            u32x4 o; o.x = pk2(a[0], a[1]); o.y = pk2(a[2], a[3]); o.z = pk2(a[4], a[5]); o.w = pk2(a[6], a[7]); xr[64 * j] = o; }
        s = wave_sum(s);
        if (F.lane == 0) rstdp[t] = 1.f / sqrtf(s * (1.f / D) + EPS);
    }
}
__device__ __forceinline__ void p10_final(Frame& F) {
    const int gw = F.vcu * NWAVES + F.wave, NGW = F.G * NWAVES; float* outp = OUTP; const float* gfin = INP(27);
    for (int t = gw; t < T; t += NGW) {
        f32x4* xr = (f32x4*)(outp + (size_t)t * D) + F.lane; const f32x4* gr = (const f32x4*)gfin + F.lane;
        f32x4 v[8]; float s = 0.f;
#pragma unroll
        for (int j = 0; j < 8; ++j) { v[j] = xr[64 * j]; s += (v[j].x * v[j].x + v[j].y * v[j].y) + (v[j].z * v[j].z + v[j].w * v[j].w); }
        const float rstd = 1.f / sqrtf(wave_sum(s) * (1.f / D) + EPS);
#pragma unroll
        for (int j = 0; j < 8; ++j) { const f32x4 g = gr[64 * j]; xr[64 * j] = v[j] * rstd * g; }
    }
}

constexpr int N_PHASES = 13;
__global__ void __launch_bounds__(NTHREADS, 2) mk_fwd(Args args) {
    extern __shared__ __attribute__((aligned(16))) unsigned char lds_raw[];
    Frame F;
    F.lds = (LAS unsigned char*)lds_raw; F.MISC = (volatile LAS unsigned*)(F.lds + MISC_OFF);
    F.wave = __builtin_amdgcn_readfirstlane((int)threadIdx.x >> 6); F.lane = (int)__builtin_amdgcn_mbcnt_hi(~0u, __builtin_amdgcn_mbcnt_lo(~0u, 0u)); F.tid = F.wave * 64 + F.lane;
    F.G = gridDim.x; { const int bx = blockIdx.x; F.vcu = (F.G % 8 == 0) ? (bx % 8) * (F.G / 8) + bx / 8 : bx; }
    for (int u = F.tid; u < (LDS_BYTES - LDSCTL_OFF) / 4; u += NTHREADS) ((LAS unsigned*)(F.lds + LDSCTL_OFF))[u] = 0u;
    __syncthreads();
    if (F.tid == 0) {
        LAS unsigned long long* tb = (LAS unsigned long long*)(F.lds + TBL_OFF);
#pragma unroll
        for (int k = 0; k < 28; ++k) tb[k] = (unsigned long long)args.in[k];
        tb[28] = (unsigned long long)args.out; tb[29] = (unsigned long long)args.ws;
    }
    const int lo = args.ph_lo, hi = args.ph_hi;
    __syncthreads();
    XcdBarrier bar; bar.bar = (unsigned*)(WSP + WS_CTL) + CW_BAR; bar.x = 0; bar.st = nullptr;
    const bool one_launch = (hi - lo) > 1;
    if (one_launch) bar = xcd_barrier_post(bar.bar, F.MISC + 8);
#ifndef PHASE_MASK
#define PHASE_MASK 0xFFFFu
#endif
#define IN(k) ((((PHASE_MASK) >> (k)) & 1u) && lo <= (k) && (k) < hi)
#define SEAM(k) do { if (IN(k) && IN((k) + 1)) xcd_barrier(bar); } while (0)
    const int bx = (int)blockIdx.x;
    volatile LAS int* ts = (volatile LAS int*)(F.MISC + 16);

#ifndef REPEAT_MASK
#define REPEAT_MASK 0u
#endif
#define PH(k, ...) do { if (IN(k)) { { __VA_ARGS__ } if (((REPEAT_MASK) >> (k)) & 1u) { if (one_launch) xcd_barrier(bar); { __VA_ARGS__ } } } SEAM(k); } while (0)
#ifndef BAR_EXTRA
#define BAR_EXTRA 0
#endif
    PH(0, p0_prologue(F););
    if (one_launch) for (int _b = 0; _b < BAR_EXTRA; ++_b) xcd_barrier(bar);
    PH(2, unsigned char* ws = WSP; SchedP1 S{(const char*)(ws + WS_XN), (const char*)(ws + WS_WIN), (const char*)(ws + WS_WB), (const char*)(ws + WS_WPS), F.G, bx};
        EpiP1 E{EpiZ{(bf16*)(ws + WS_Z)}, EpiPlain{(bf16*)(ws + WS_W2), 1024}}; g8::gemm_phase<false>(F.lds, F.wave, S, E);
        { const int nu = 896 + 32, rmax = (nu + F.G - 1) / F.G, nfull = nu - (rmax - 1) * F.G;
          int nidle = F.G - nfull, rank = bx - nfull; if (nidle <= 0) { nidle = F.G; rank = bx; }
          if (rank >= 0) p0_transposes(F, ws, TI_EARLY, TI_MID, rank * NWAVES + F.wave, nidle * NWAVES); });
    PH(3, p2_fast(F););
    PH(5, unsigned char* ws = WSP; SchedU S{(const char*)(ws + WS_YD), (const char*)(ws + WS_WA), (const char*)(ws + WS_W2), F.G, bx}; EpiU E{(bf16*)(ws + WS_XN), (const bf16*)(ws + WS_Z)}; g8::gemm_phase<false>(F.lds, F.wave, S, E););
    PH(6, unsigned char* ws = WSP; SchedDense S{(const char*)(ws + WS_XN), (const char*)(ws + WS_WOUT), 4096, 4096, 32, 32, 8, F.G, bx}; EpiX1 E{INP(0), (bf16*)(ws + WS_YD)}; g8::gemm_phase<false>(F.lds, F.wave, S, E););
    PH(7, p5_fast(F););
    PH(8, moe_table(F, ts); unsigned char* ws = WSP;
        { SchedMoeUp S{(const char*)(ws + WS_YD), (const char*)(ws + WS_WGU), (const int*)(ws + WS_LIST), (const int*)(ws + WS_CTL) + CW_CNT, ts, F.G, F.vcu};
          EpiAct E{(bf16*)(ws + WS_ACT), (const float*)(ws + WS_MISC + MI_RSTD2)}; g8::gemm_phase<true>(F.lds, F.wave, S, E); }
        { const int nup = 4 * __builtin_amdgcn_readfirstlane(ts[16]); int n2 = nup - F.G; n2 = n2 < 0 ? 0 : n2; int nfree = F.G - n2; int rank = F.vcu - n2; if (nfree <= 0) { nfree = F.G; rank = F.vcu; } nfree = __builtin_amdgcn_readfirstlane(nfree); rank = __builtin_amdgcn_readfirstlane(rank);
          SchedE S{(const char*)(ws + WS_PB), (const char*)(ws + WS_WPP), 0, nfree, rank}; EpiPlain E{(bf16*)(ws + WS_XN), D}; g8::gemm_phase<false>(F.lds, F.wave, S, E);
          if (rank >= 0) p0_transposes(F, ws, TI_MID, TI_ALL, rank * NWAVES + F.wave, nfree * NWAVES); });
    PH(9, moe_table(F, ts); unsigned char* ws = WSP;
        SchedMoeDown S{(const char*)(ws + WS_ACT), (const char*)(ws + WS_WD), (const int*)(ws + WS_LIST), (const int*)(ws + WS_CTL) + CW_CNT, ts, F.G, F.vcu};
        EpiDown E{(bf16*)(ws + WS_YS), (const int*)(ws + WS_LIST), (const float*)(ws + WS_WL)}; g8::gemm_phase<false>(F.lds, F.wave, S, E););
    PH(10, p8_combine(F););
    PH(11, unsigned char* ws = WSP;
        SchedDense S{(const char*)(ws + WS_YD), (const char*)(ws + WS_WPG), 4096, 4096, 32, 32, 8, F.G, bx};
        EpiPle E{OUTP, (const bf16*)(ws + WS_YD), (const bf16*)(ws + WS_XN), (const float*)(ws + WS_MISC + MI_RSTDP)}; g8::gemm_phase<false>(F.lds, F.wave, S, E););
    PH(12, p10_final(F););
#undef PH
#undef IN
#undef SEAM
}

extern "C" void kernel_launch(void* const* d_in, const int* in_sizes, int n_in, void* d_out, int out_size, void* d_ws, size_t ws_size, hipStream_t stream) {
    static int grid = 0;
    if (grid == 0) {
        if (n_in != 28 || in_sizes[0] != T * D || out_size != T * D || ws_size < WS_END) { fprintf(stderr, "kernel_launch: unexpected shapes / workspace (n_in %d, ws %zu < %zu)\n", n_in, ws_size, (size_t)WS_END); grid = -1; return; }
        int dev = 0, cus = 0, per_cu = 0;
        if (hipGetDevice(&dev) != hipSuccess || hipDeviceGetAttribute(&cus, hipDeviceAttributeMultiprocessorCount, dev) != hipSuccess) { grid = -1; return; }
        if (hipFuncSetAttribute((const void*)mk_fwd, hipFuncAttributeMaxDynamicSharedMemorySize, LDS_BYTES) != hipSuccess) { fprintf(stderr, "kernel_launch: hipFuncSetAttribute failed\n"); grid = -1; return; }
        if (hipOccupancyMaxActiveBlocksPerMultiprocessor(&per_cu, (const void*)mk_fwd, NTHREADS, LDS_BYTES) != hipSuccess || per_cu < 1) { fprintf(stderr, "kernel_launch: occupancy query says %d blocks/CU\n", per_cu); (void)hipGetLastError(); grid = -1; return; }
        grid = cus;
    }
    if (grid < 0) return;
    (void)hipMemsetAsync((char*)d_ws + WS_CTL, 0, CTL_ZERO_BYTES, stream);
    Args a{};
    for (int i = 0; i < 28; ++i) a.in[i] = (const float*)d_in[i];
    a.out = (float*)d_out; a.ws = (unsigned char*)d_ws;
#if MK_N_LAUNCHES == 1
    a.ph_lo = 0; a.ph_hi = N_PHASES;
    hipLaunchKernelGGL(mk_fwd, dim3(grid), dim3(NTHREADS), LDS_BYTES, stream, a);
#else
    for (int p = 0; p < N_PHASES; ++p) { a.ph_lo = p; a.ph_hi = p + 1; hipLaunchKernelGGL(mk_fwd, dim3(grid), dim3(NTHREADS), LDS_BYTES, stream, a); }
#endif
}
```

```cpp
#include <hip/hip_runtime.h>
#include <cstdio>
#include <cstdint>

#ifndef MK_N_LAUNCHES
#define MK_N_LAUNCHES 1
#endif

#define LAS __attribute__((address_space(3)))
#define GAS __attribute__((address_space(1)))
typedef unsigned short bf16;
typedef short bf16x8 __attribute__((ext_vector_type(8)));
typedef float f32x4 __attribute__((ext_vector_type(4)));
typedef float f32x2 __attribute__((ext_vector_type(2)));
typedef unsigned u32x4 __attribute__((ext_vector_type(4)));
typedef unsigned u32x2 __attribute__((ext_vector_type(2)));

constexpr int D = 2048, BATCH = 4, SEQ = 2048, T = BATCH * SEQ;
constexpr int PLE = 256, LRU_W = 1024, HD = 64, POOL_W = 1024, PGD = 256;
constexpr int IN_COLS = 7168, NE = 16, DE = 512;
constexpr float EPS = 1e-6f;
constexpr int NWAVES = 8, NTHREADS = 512;

constexpr size_t MiB = 1u << 20;
constexpr size_t WS_CTL = 0, CTL_ZERO_BYTES = 1 * MiB;
constexpr size_t WS_WIN = 1 * MiB;
constexpr size_t WS_WA = 29 * MiB;
constexpr size_t WS_WB = 33 * MiB;
constexpr size_t WS_W2 = 37 * MiB;
constexpr size_t WS_WOUT = 41 * MiB;
constexpr size_t WS_WPG = 49 * MiB;
constexpr size_t WS_WPP = 57 * MiB;
constexpr size_t WS_WPS = 58 * MiB;
constexpr size_t WS_MISC = 59 * MiB;
constexpr size_t WS_WGU = 60 * MiB;
constexpr size_t WS_WD = 124 * MiB;
constexpr size_t WS_XN = 156 * MiB;
constexpr size_t WS_Z = 188 * MiB;
constexpr size_t WS_YS = 188 * MiB;
constexpr size_t WS_ACT = 252 * MiB;
constexpr size_t WS_E = 272 * MiB;
constexpr size_t WS_YD = 300 * MiB;
constexpr size_t WS_PB = 332 * MiB;
constexpr size_t WS_LISTS = 336 * MiB;
constexpr size_t WS_END = 337 * MiB;
constexpr size_t MI_WRT = 524288  ;
constexpr size_t MI_RSTD2 = 0, MI_RSTDP = 32768, MI_CST = 65536  , MI_WRG = 131072  ;
constexpr size_t WS_LIST = WS_LISTS, WS_WL = WS_LISTS + 524288;
constexpr int CW_BAR = 4096;
constexpr int CW_CNT = 64;
constexpr size_t CTL_GRAN = 262144;

constexpr int RING_BYTES = 131072;
constexpr int LDSCTL_OFF = RING_BYTES, MISC_OFF = LDSCTL_OFF + 320;
constexpr int TBL_OFF = MISC_OFF + 256;
constexpr int LDS_BYTES = 147456;

#define RLX_AGENT __ATOMIC_RELAXED, __HIP_MEMORY_SCOPE_AGENT
#define LDS_WAIT() asm volatile("s_waitcnt lgkmcnt(0)" ::: "memory")
__device__ __forceinline__ unsigned f2bf(float f) { unsigned u = __builtin_bit_cast(unsigned, f); return (u + 0x7fffu + ((u >> 16) & 1u)) >> 16; }
__device__ __forceinline__ unsigned pk2(float lo, float hi) { return f2bf(lo) | (f2bf(hi) << 16); }
__device__ __forceinline__ float bf2f(unsigned b) { return __builtin_bit_cast(float, b << 16); }
__device__ __forceinline__ float bflo(unsigned w) { return __builtin_bit_cast(float, w << 16); }
__device__ __forceinline__ float bfhi(unsigned w) { return __builtin_bit_cast(float, w & 0xffff0000u); }
__device__ __forceinline__ float wave_sum(float v) {
#pragma unroll
    for (int o = 1; o < 64; o <<= 1) v += __shfl_xor(v, o);
    return v;
}
__device__ __forceinline__ float fsigmoid(float v) { return __builtin_amdgcn_rcpf(1.f + __expf(-v)); }
__device__ __forceinline__ float gelu_tanh(float v) { const float u = 1.5957691216057308f * (v + 0.044715f * v * v * v); return v * fsigmoid(u); }

__device__ __forceinline__ const void* ld_ptr(LAS unsigned char* lds, int k) {
    const volatile LAS unsigned* p = (const volatile LAS unsigned*)(lds + TBL_OFF) + 2 * k;
    const unsigned lo = __builtin_amdgcn_readfirstlane(p[0]), hi = __builtin_amdgcn_readfirstlane(p[1]);
    return (const void*)(((unsigned long long)hi << 32) | lo);
}
#define INP(k) ((const float*)ld_ptr(F.lds, (k)))
#define OUTP ((float*)ld_ptr(F.lds, 28))
#define WSP ((unsigned char*)ld_ptr(F.lds, 29))

namespace g8 {
constexpr int BM = 256, BK = 64, HALF = 128, HTB = HALF * BK * 2, NXCD = 8, WGM = 8;
__host__ __device__ __forceinline__ int lds_byte(int r, int c) { const int st = (r >> 4) * 2 + (c >> 5), rr = r & 15, cc = c & 31, ob = rr * 64 + cc * 2; return st * 1024 + (ob ^ (((ob >> 9) & 1) << 5)); }
__host__ __device__ __forceinline__ void stage_rc(int b, int& R, int& C) { const int st = b / 1024, sb = b % 1024, swz = sb ^ (((sb >> 9) & 1) << 5); R = (st >> 1) * 16 + swz / 64; C = (st & 1) * 32 + (swz % 64) / 2; }
__host__ __device__ __forceinline__ int perm32(int rho) { const int n = rho >> 4, i = rho & 15; return 8 * (i >> 2) + 4 * n + (i & 3); }

struct GU {
    const char* A; const char* B;
    const int* gl; int gn;
    unsigned lda;
    int nt;
    int pm, pn, aux;
};
__device__ __forceinline__ void tile_of(int L, int nM, int nN, int& pm, int& pn) {
    const int nwg = nM * nN; int wgid = L; { const int q = nwg / NXCD, r = nwg % NXCD, xcd = wgid % NXCD, off = wgid / NXCD; wgid = (xcd < r ? xcd * (q + 1) : r * (q + 1) + (xcd - r) * q) + off; }
    const int nig = WGM * nN, gid = wgid / nig, fm = gid * WGM, gsz = (nM - fm) < WGM ? (nM - fm) : WGM;
    pm = fm + ((wgid % nig) % gsz); pn = (wgid % nig) / gsz;
}
__device__ __forceinline__ unsigned cvt_pk_bf16(float lo, float hi) { unsigned r; asm volatile("v_cvt_pk_bf16_f32 %0, %1, %2" : "=v"(r) : "v"(lo), "v"(hi)); return r; }

__device__ __forceinline__ const char* uni_ptr(const char* p) { const unsigned long long v = (unsigned long long)p; const unsigned lo = __builtin_amdgcn_readfirstlane((unsigned)v), hi = __builtin_amdgcn_readfirstlane((unsigned)(v >> 32)); return (const char*)(((unsigned long long)hi << 32) | lo); }
__device__ __forceinline__ void uni_unit(GU& u) { u.A = uni_ptr(u.A); u.B = uni_ptr(u.B); u.lda = __builtin_amdgcn_readfirstlane(u.lda); u.nt = __builtin_amdgcn_readfirstlane(u.nt); }
template <int OFF> __device__ __forceinline__ void glds16(const char* sbase, unsigned voff, unsigned lds_base) {
    unsigned keep;
    asm volatile("s_mov_b32 %0, m0\n\ts_add_u32 m0, %3, %4\n\ts_nop 2\n\tglobal_load_lds_dwordx4 %1, %2\n\ts_mov_b32 m0, %0" : "=&s"(keep) : "v"(voff), "s"(sbase), "s"(lds_base), "i"(OFF) : "memory", "scc");
}
template <bool GATHER, class Epi, class Sched>
__device__ __forceinline__ void gemm_phase(LAS unsigned char* lds, int wave, const Sched& S, const Epi& E) {
    const int wid = wave, lane = (int)__builtin_amdgcn_mbcnt_hi(~0u, __builtin_amdgcn_mbcnt_lo(~0u, 0u)), tid = wid * 64 + lane;
    const int wr = wid >> 2, wc = wid & 3, fr = lane & 15, fq = lane >> 4;
    const unsigned ldsbw = (unsigned)(uintptr_t)lds + (unsigned)wid * 1024u;
    const int aoff = lds_byte(wr * 64 + fr, fq * 8), boff = lds_byte(wc * 32 + fr, fq * 8);
#define G8_OFFS(u, vA, vB) do { int _t = tid; asm volatile("" : "+v"(_t)); int sR[2], sRp[2], sC[2];     \
        _Pragma("unroll") for (int _i = 0; _i < 2; ++_i) { stage_rc(_t * 16 + _i * 8192, sR[_i], sC[_i]); sRp[_i] = (sR[_i] & ~31) + perm32(sR[_i] & 31); } \
        _Pragma("unroll") for (int _h = 0; _h < (GATHER ? 2 : 1); ++_h) _Pragma("unroll") for (int _i = 0; _i < 2; ++_i) { const int _r = _h * HALF + sR[_i]; int _row = _r; \
            if (GATHER && (u).gl) { _row = 0; if (_r < (u).gn) _row = (u).gl[_r] >> 1; } vA[_h][_i] = (unsigned)_row * (u).lda + (unsigned)sC[_i] * 2u; } \
        _Pragma("unroll") for (int _i = 0; _i < 2; ++_i) vB[_i] = (unsigned)sRp[_i] * ((unsigned)(u).nt * 128u) + (unsigned)sC[_i] * 2u; } while (0)
#define G8_SA(b, h) (((b) * 2 + (h)) * HTB)
#define G8_SB(b, h) ((4 + (b) * 2 + (h)) * HTB)
#define G8_STAGE(bufoff, gbase, voff) do { const char* _gb = uni_ptr((const char*)(gbase)); glds16<(bufoff)>(_gb, (voff)[0], ldsbw); glds16<(bufoff) + 8192>(_gb, (voff)[1], ldsbw); } while (0)
#define G8_LDA(dst, b, h) do { _Pragma("unroll") for (int m = 0; m < 4; ++m) _Pragma("unroll") for (int k = 0; k < 2; ++k) dst[m][k] = *(const LAS bf16x8*)(lds + G8_SA(b, h) + aoff + m * 2048 + k * 1024); } while (0)
#define G8_LDB(dst, b, h) do { _Pragma("unroll") for (int n = 0; n < 2; ++n) _Pragma("unroll") for (int k = 0; k < 2; ++k) dst[n][k] = *(const LAS bf16x8*)(lds + G8_SB(b, h) + boff + n * 2048 + k * 1024); } while (0)
#define G8_MMA(ai, bj, At, Bt) do { __builtin_amdgcn_s_setprio(1); _Pragma("unroll") for (int m = 0; m < 4; ++m) _Pragma("unroll") for (int n = 0; n < 2; ++n) _Pragma("unroll") for (int k = 0; k < 2; ++k) \
        acc[ai][bj][m][n] = __builtin_amdgcn_mfma_f32_16x16x32_bf16(Bt[n][k], At[m][k], acc[ai][bj][m][n], 0, 0, 0); __builtin_amdgcn_s_setprio(0); } while (0)
#define G8_WAIT_V(n) asm volatile("s_waitcnt vmcnt(" #n ")" ::: "memory")
#define G8_WAIT_L(n) asm volatile("s_waitcnt lgkmcnt(" #n ")" ::: "memory")
#define G8_BAR __builtin_amdgcn_s_barrier()
#define G8_SCHED __builtin_amdgcn_sched_barrier(0)
    GU cur, nxt; int ui = 0;
    if (!S.next(0, cur)) return;
    uni_unit(cur);
    f32x4 acc[2][2][4][2];
#pragma unroll
    for (int a = 0; a < 2; ++a)
#pragma unroll
        for (int b = 0; b < 2; ++b)
#pragma unroll
            for (int m = 0; m < 4; ++m)
#pragma unroll
                for (int n = 0; n < 2; ++n) acc[a][b][m][n] = (f32x4){0.f, 0.f, 0.f, 0.f};
    bf16x8 At[4][2], B0[2][2], B1[2][2];
    unsigned vA[2][2], vB[2];
    S.a_ready(cur, wid);
    G8_OFFS(cur, vA, vB);
    const char* cA = cur.A; const char* cB = cur.B; unsigned chB = HALF * (unsigned)cur.nt * 128u, chA = GATHER ? 0u : HALF * cur.lda;
    {
        G8_STAGE(G8_SB(0, 0), cB, vB); G8_STAGE(G8_SB(0, 1), cB + chB, vB); G8_STAGE(G8_SA(0, 0), cA, vA[0]); G8_STAGE(G8_SA(0, 1), cA + chA, vA[GATHER ? 1 : 0]);
        if (wr == 1) G8_BAR;
        G8_WAIT_V(2); G8_BAR;
        G8_STAGE(G8_SB(1, 0), cB + 128, vB); G8_STAGE(G8_SA(1, 0), cA + 128, vA[0]); G8_STAGE(G8_SB(1, 1), cB + chB + 128, vB);
        G8_WAIT_V(6); G8_BAR;
    }
    for (;;) {
        const bool has_next = S.next(ui + 1, nxt); if (has_next) uni_unit(nxt);
        int nt = __builtin_amdgcn_readfirstlane(cur.nt); asm volatile("" : "+s"(nt));
        for (int t = 0; t < nt; t += 2) {
            const bool last = (t == nt - 2);
            const char* a1 = cA + (size_t)(t + 1) * 128;
            G8_LDB(B0, 0, 0); G8_LDB(B1, 0, 1); G8_SCHED; G8_LDA(At, 0, 0); G8_STAGE(G8_SA(1, 1), a1 + chA, vA[GATHER ? 1 : 0]);
            const char* a2; const char* b2; unsigned xhB, xhA;
            if (last) {
                if (has_next) { S.a_ready(nxt, wid); G8_OFFS(nxt, vA, vB); a2 = nxt.A; b2 = nxt.B; xhB = HALF * (unsigned)nxt.nt * 128u; xhA = GATHER ? 0u : HALF * nxt.lda; }
                else { a2 = cA; b2 = cB; xhB = chB; xhA = chA; }
            } else { a2 = cA + (size_t)(t + 2) * 128; b2 = cB + (size_t)(t + 2) * 128; xhB = chB; xhA = chA; }
            const char* a3 = a2 + 128; const char* b3 = b2 + 128;
            G8_WAIT_V(8); G8_WAIT_L(0); G8_BAR; G8_MMA(0, 0, At, B0); G8_MMA(0, 1, At, B1); G8_BAR; G8_SCHED;
            G8_LDA(At, 0, 1); G8_STAGE(G8_SB(0, 0), b2, vB); G8_STAGE(G8_SB(0, 1), b2 + xhB, vB); G8_STAGE(G8_SA(0, 0), a2, vA[0]);
            G8_WAIT_V(8); G8_WAIT_L(0); G8_BAR; G8_MMA(1, 0, At, B0); G8_MMA(1, 1, At, B1); G8_BAR; G8_SCHED;
            G8_LDB(B0, 1, 0); G8_LDB(B1, 1, 1); G8_SCHED; G8_LDA(At, 1, 0); G8_STAGE(G8_SA(0, 1), a2 + xhA, vA[GATHER ? 1 : 0]);
            G8_WAIT_V(8); G8_WAIT_L(0); G8_BAR; G8_MMA(0, 0, At, B0); G8_MMA(0, 1, At, B1); G8_BAR; G8_SCHED;
            G8_LDA(At, 1, 1); G8_STAGE(G8_SB(1, 0), b3, vB); G8_STAGE(G8_SB(1, 1), b3 + xhB, vB); G8_STAGE(G8_SA(1, 0), a3, vA[0]);
            G8_WAIT_V(8); G8_WAIT_L(0); G8_BAR; G8_MMA(1, 0, At, B0); G8_MMA(1, 1, At, B1); G8_BAR; G8_SCHED;
        }
        if (wr == 0) G8_BAR;
        E(acc, cur, wr, wc, fr, fq);
        S.done(cur, lane);
        if (!has_next) break;
#pragma unroll
        for (int a = 0; a < 2; ++a)
#pragma unroll
            for (int b = 0; b < 2; ++b)
#pragma unroll
                for (int m = 0; m < 4; ++m)
#pragma unroll
                    for (int n = 0; n < 2; ++n) acc[a][b][m][n] = (f32x4){0.f, 0.f, 0.f, 0.f};
        cur = nxt; cA = cur.A; cB = cur.B; chB = HALF * (unsigned)cur.nt * 128u; chA = GATHER ? 0u : HALF * cur.lda; ++ui;
        if (wr == 1) G8_BAR;
    }
    G8_WAIT_V(0);
    G8_BAR;
#undef G8_OFFS
#undef G8_SA
#undef G8_SB
#undef G8_STAGE
#undef G8_LDA
#undef G8_LDB
#undef G8_MMA
#undef G8_WAIT_V
#undef G8_WAIT_L
#undef G8_BAR
#undef G8_SCHED
}
}
using g8::GU;

#define XB_TMO      128
#define XB_XCNT(j)  (256  + 64 * (j))
#define XB_XSUB(j)  (1280 + 64 * (j))
#define XB_XGEN(j)  (2304 + 64 * (j))
#define XB_TOP      3328
#define XB_TOPGEN   3392
#define XCD_BAR_WORDS 3456
#define XB_SPIN_CAP (1u << 18)
__device__ __forceinline__ unsigned xb_ld(unsigned* p)              { return __hip_atomic_load(p, __ATOMIC_RELAXED, __HIP_MEMORY_SCOPE_AGENT); }
__device__ __forceinline__ unsigned xb_add(unsigned* p, unsigned v) { return __hip_atomic_fetch_add(p, v, __ATOMIC_RELAXED, __HIP_MEMORY_SCOPE_AGENT); }
__device__ __forceinline__ unsigned xb_xcc_id() { return (unsigned)__builtin_amdgcn_s_getreg((3 << 11) | 20) & 0xFu; }
#define XB_SPIN(cond, bar) do { unsigned _sp = 0; while (cond) { __builtin_amdgcn_s_sleep(1); \
    if ((++_sp & 255u) == 0u) { if (xb_ld(&(bar)[XB_TMO])) break; if (_sp > XB_SPIN_CAP) { atomicAdd(&(bar)[XB_TMO], 1u); break; } } } } while (0)
struct XcdBarrier { unsigned* bar; unsigned x; volatile LAS unsigned* st; };
__device__ __forceinline__ XcdBarrier xcd_barrier_post(unsigned* bar, volatile LAS unsigned* st) {
    XcdBarrier b; b.bar = bar; b.x = xb_xcc_id(); b.st = st;
    if (threadIdx.x == 0) (void)xb_add(&bar[XB_XCNT(b.x)], 1u);
    return b;
}
__device__ __forceinline__ void xcd_barrier_complete(unsigned* bar, unsigned x, unsigned& nloc, unsigned& nx) {
    const unsigned G = gridDim.x * gridDim.y * gridDim.z;
    unsigned sum, cnt, mine, sp = 0u;
    for (;;) {
        sum = 0u; cnt = 0u; mine = 0u;
#pragma unroll
        for (unsigned j = 0; j < 16; ++j) { const unsigned c = xb_ld(&bar[XB_XCNT(j)]); sum += c; cnt += (c > 0u) ? 1u : 0u; mine = (j == x) ? c : mine; }
        if (sum == G) break;
        __builtin_amdgcn_s_sleep(1);
        if ((++sp & 255u) == 0u) { if (xb_ld(&bar[XB_TMO])) break; if (sp > XB_SPIN_CAP) { atomicAdd(&bar[XB_TMO], 1u); break; } }
    }
    nloc = mine > 0u ? mine : 1u; nx = cnt > 0u ? cnt : 1u;
}
__device__ __forceinline__ void xcd_barrier(const XcdBarrier& b) {
    asm volatile("s_waitcnt vmcnt(0)" ::: "memory");
    __syncthreads();
    if (threadIdx.x == 0) {
        unsigned* bar = b.bar;
        __builtin_amdgcn_s_waitcnt(0);
        unsigned nloc = b.st[0], nx = b.st[1];
        if (nloc == 0u) { xcd_barrier_complete(bar, b.x, nloc, nx); b.st[0] = nloc; b.st[1] = nx; }
        const unsigned old = xb_add(&bar[XB_XSUB(b.x)], 1u);
        const unsigned gen = old / nloc;
        if (old + 1u == (gen + 1u) * nloc) {
            __builtin_amdgcn_fence(__ATOMIC_RELEASE, "agent");
            asm volatile("s_waitcnt vmcnt(0)" ::: "memory");
            const unsigned og = xb_add(&bar[XB_TOP], 1u);
            const unsigned tg = og / nx;
            if (og + 1u == (tg + 1u) * nx) xb_add(&bar[XB_TOPGEN], 1u);
            else XB_SPIN(xb_ld(&bar[XB_TOPGEN]) == tg, bar);
            __builtin_amdgcn_fence(__ATOMIC_ACQUIRE, "agent");
            xb_add(&bar[XB_XGEN(b.x)], 1u);
            asm volatile("s_waitcnt vmcnt(0)" ::: "memory");
        } else {
            XB_SPIN(xb_ld(&bar[XB_XGEN(b.x)]) == gen, bar);
            __builtin_amdgcn_fence(__ATOMIC_ACQUIRE, "agent");
            asm volatile("s_waitcnt vmcnt(0)" ::: "memory");
        }
    }
    __syncthreads();
}

struct Args { const float* in[28]; float* out; unsigned char* ws; int ph_lo, ph_hi; };
struct Frame {
    LAS unsigned char* lds; volatile LAS unsigned* MISC;
    int tid, lane, wave, vcu, G;
};

struct TItem { const float* src; bf16* dst; const float* ks; int ldw, ldt; };
__device__ __forceinline__ bool p0_decode(Frame& F, unsigned char* ws, int it, TItem& t) {
    constexpr int I_IN = (D / 64) * (IN_COLS / 32), I_A = (LRU_W / 64) * (D / 32), I_O = (D / 64) * (D / 32), I_PP = (PLE / 64) * (D / 32);
    constexpr int I_EG = (D / 64) * (DE / 32), I_ED = (DE / 64) * (D / 32);
    constexpr int NITEMS = I_IN + 2 * I_A + 2 * I_O + I_PP + 2 * NE * I_EG + NE * I_ED;
    if (it >= NITEMS) return false;
    int r = it; const float* W; bf16* WT; int ldw, ldt, kb, n0, drow0; const float* ks = nullptr;
    if (r < I_IN) { const int nb = IN_COLS / 32; W = INP(3); ldw = IN_COLS; kb = r / nb; n0 = 32 * (r % nb); WT = (bf16*)(ws + WS_WIN); ldt = D; drow0 = n0; }
    else if ((r -= I_IN) < I_A) { const int nb = D / 32; W = INP(13); ldw = D; kb = r / nb; n0 = 32 * (r % nb); WT = (bf16*)(ws + WS_WA); ldt = LRU_W; drow0 = n0; }
    else if ((r -= I_A) < I_A) { const int nb = D / 32; W = INP(14); ldw = D; kb = r / nb; n0 = 32 * (r % nb); WT = (bf16*)(ws + WS_WB); ldt = POOL_W; drow0 = n0; }
    else if ((r -= I_A) < I_O) { const int nb = D / 32; W = INP(15); ldw = D; kb = r / nb; n0 = 32 * (r % nb); WT = (bf16*)(ws + WS_WOUT); ldt = D; drow0 = n0; }
    else if ((r -= I_O) < I_O) { const int nb = D / 32; W = INP(25); ldw = D; kb = r / nb; n0 = 32 * (r % nb); WT = (bf16*)(ws + WS_WPG); ldt = D; drow0 = n0; ks = INP(24); }
    else if ((r -= I_O) < I_PP) { const int nb = D / 32; W = INP(26); ldw = D; kb = r / nb; n0 = 32 * (r % nb); WT = (bf16*)(ws + WS_WPP); ldt = PLE; drow0 = n0; }
    else if ((r -= I_PP) < 2 * NE * I_EG) {
        const int up = r / (NE * I_EG); r -= up * NE * I_EG; const int e = r / I_EG; r -= e * I_EG; const int nb = DE / 32; kb = r / nb; n0 = 32 * (r % nb);
        W = (up ? INP(22) : INP(21)) + (size_t)e * D * DE; ldw = DE; WT = (bf16*)(ws + WS_WGU); ldt = D; drow0 = e * 1024 + (n0 / 128) * 256 + up * 128 + (n0 % 128); ks = INP(16); }
    else { r -= 2 * NE * I_EG; const int e = r / I_ED; r -= e * I_ED; const int nb = D / 32; kb = r / nb; n0 = 32 * (r % nb);
        W = INP(23) + (size_t)e * DE * D; ldw = D; WT = (bf16*)(ws + WS_WD); ldt = DE; drow0 = e * D + n0; }
    t.src = W + (size_t)(64 * kb) * ldw + n0; t.dst = WT + (size_t)drow0 * ldt + 64 * kb; t.ks = ks ? ks + 64 * kb : nullptr; t.ldw = ldw; t.ldt = ldt; return true;
}
__device__ __forceinline__ void p0_load(const TItem& t, float (&v)[32], int lane) {
    const float* p = t.src + (size_t)(lane >> 5) * t.ldw + (lane & 31);
#pragma unroll
    for (int i = 0; i < 32; ++i) v[i] = p[(size_t)(2 * i) * t.ldw];
}
__device__ __forceinline__ void p0_store(const TItem& t, const float (&v)[32], LAS float* scr, int lane) {
    if (t.ks) {
#pragma unroll
        for (int i = 0; i < 32; ++i) scr[(2 * i + (lane >> 5)) * 33 + (lane & 31)] = v[i] * t.ks[2 * i + (lane >> 5)];
    } else {
#pragma unroll
        for (int i = 0; i < 32; ++i) scr[(2 * i + (lane >> 5)) * 33 + (lane & 31)] = v[i];
    }
    LDS_WAIT(); asm volatile("" ::: "memory");
    const int c = lane & 7;
#pragma unroll
    for (int j = 0; j < 4; ++j) { const int n = (lane >> 3) + 8 * j; const LAS float* s = scr + (8 * c) * 33 + n;
        u32x4 o; o.x = pk2(s[0 * 33], s[1 * 33]); o.y = pk2(s[2 * 33], s[3 * 33]); o.z = pk2(s[4 * 33], s[5 * 33]); o.w = pk2(s[6 * 33], s[7 * 33]);
        *(u32x4*)(t.dst + (size_t)n * t.ldt + 8 * c) = o; }
    LDS_WAIT(); asm volatile("" ::: "memory");
}
__device__ __forceinline__ void p0_prologue(Frame& F) {
    LAS float* scr = (LAS float*)(F.lds + F.wave * 16384);
    const int gw = F.vcu * NWAVES + F.wave, NGW = F.G * NWAVES;
    unsigned char* ws = WSP;
    {
        TItem ta, tb; float va[32], vb[32]; int it = gw;
        bool ha = p0_decode(F, ws, it, ta); if (ha) p0_load(ta, va, F.lane);
        while (ha) {
            const bool hb = p0_decode(F, ws, it + NGW, tb); if (hb) p0_load(tb, vb, F.lane);
            p0_store(ta, va, scr, F.lane);
            if (!hb) break;
            it += 2 * NGW; ha = p0_decode(F, ws, it, ta); if (ha) p0_load(ta, va, F.lane);
            p0_store(tb, vb, scr, F.lane);
        }
    }
    const size_t gt = (size_t)(F.vcu * NTHREADS + F.tid), NGT = (size_t)F.G * NTHREADS;
    for (size_t i = gt; i < (size_t)4 * PGD * PGD / 4; i += NGT) { const f32x4 v = ((const f32x4*)INP(11))[i]; const int g = (int)(i / (PGD * PGD / 4)), d0 = (int)((i * 4) % PGD); const float* sc = INP(12) + g * PGD + d0;
        u32x2 o; o.x = pk2(v.x * sc[0], v.y * sc[1]); o.y = pk2(v.z * sc[2], v.w * sc[3]); ((u32x2*)(ws + WS_WPS))[i] = o; }
    for (size_t i = gt; i < (size_t)T * PLE / 4; i += NGT) { const f32x4 v = ((const f32x4*)INP(1))[i]; u32x2 o; o.x = pk2(v.x, v.y); o.y = pk2(v.z, v.w); ((u32x2*)(ws + WS_PB))[i] = o; }
    for (size_t i = gt; i < (size_t)16 * 8 * 64; i += NGT) { const int h = (int)(i >> 9), row = (int)(i >> 6) & 7, j = (int)i & 63, c = h * 64 + j; float v;
        if (row < 4) v = INP(4)[row * LRU_W + c]; else if (row == 4) v = INP(5)[c]; else if (row == 5) v = INP(7)[c]; else if (row == 6) v = INP(9)[c]; else v = 8.0f * log1pf(expf(-INP(10)[c]));
        ((float*)(ws + WS_MISC + MI_CST))[i] = v; }
    for (size_t i = gt; i < (size_t)16 * 24 * 64; i += NGT) { const int h = (int)(i / (24 * 64)), fi = (int)(i / 64) % 24, ln = (int)i & 63, nt = fi >> 1, sx = fi & 1, fr_ = ln & 15, fq_ = ln >> 4;
        float v[8];
#pragma unroll
        for (int j = 0; j < 8; ++j) { const int k = 32 * sx + 8 * fq_ + j;
            if (nt < 4) v[j] = INP(6)[(h * 64 + k) * 64 + 16 * nt + fr_]; else if (nt < 8) v[j] = INP(8)[(h * 64 + k) * 64 + 16 * (nt - 4) + fr_]; else v[j] = (k == 16 * (nt - 8) + fr_) ? 1.0f : 0.0f; }
        u32x4 o; o.x = pk2(v[0], v[1]); o.y = pk2(v[2], v[3]); o.z = pk2(v[4], v[5]); o.w = pk2(v[6], v[7]); ((u32x4*)(ws + WS_MISC + MI_WRG))[i] = o; }
    for (size_t i = gt; i < (size_t)64 * 2 * 64; i += NGT) { const int ks = (int)(i >> 7), nt = (int)(i >> 6) & 1, ln = (int)i & 63, fr_ = ln & 15, fq_ = ln >> 4, n = 16 * nt + fr_;
        float hi[8], lo[8];
#pragma unroll
        for (int j = 0; j < 8; ++j) { const int k = 32 * ks + 8 * fq_ + j; float v = 0.f; if (n < 4) v = INP(17)[k * 4 + n]; else if (n < 20) v = INP(19)[k * 16 + (n - 4)];
            v *= INP(16)[k]; hi[j] = bf2f(f2bf(v)); lo[j] = v - hi[j]; }
        u32x4 oh, ol; oh.x = pk2(hi[0], hi[1]); oh.y = pk2(hi[2], hi[3]); oh.z = pk2(hi[4], hi[5]); oh.w = pk2(hi[6], hi[7]); ol.x = pk2(lo[0], lo[1]); ol.y = pk2(lo[2], lo[3]); ol.z = pk2(lo[4], lo[5]); ol.w = pk2(lo[6], lo[7]);
        u32x4* dst = (u32x4*)(ws + WS_MISC + MI_WRT) + ((size_t)(ks * 2 + nt) * 2) * 64 + ln; dst[0] = oh; dst[64] = ol; }
    for (int m = gw; m < T; m += NGW) {
        const f32x4* xr = (const f32x4*)(INP(0) + (size_t)m * D) + F.lane; const f32x4* gr = (const f32x4*)INP(2) + F.lane;
        f32x4 v[8]; float s = 0.f;
#pragma unroll
        for (int j = 0; j < 8; ++j) { v[j] = xr[64 * j]; s += (v[j].x * v[j].x + v[j].y * v[j].y) + (v[j].z * v[j].z + v[j].w * v[j].w); }
        const float rstd = 1.f / sqrtf(wave_sum(s) * (1.f / D) + EPS);
        u32x2* o8 = (u32x2*)(ws + WS_XN + (size_t)m * D * 2) + F.lane;
#pragma unroll
        for (int j = 0; j < 8; ++j) { const f32x4 g = gr[64 * j]; u32x2 o; o.x = pk2(v[j].x * rstd * g.x, v[j].y * rstd * g.y); o.y = pk2(v[j].z * rstd * g.z, v[j].w * rstd * g.w); o8[64 * j] = o; }
    }
}

struct SchedDense { __device__ __forceinline__ void a_ready(const GU&, int) const {} __device__ __forceinline__ void done(const GU&, int) const {}
    const char* A; const char* B; unsigned lda, ldb; int nt, nM, nN, G, c;
    __device__ __forceinline__ bool next(int i, GU& u) const {
        const int L = i * G + c; if (L >= nM * nN) return false;
        g8::tile_of(L, nM, nN, u.pm, u.pn);
        u.A = A + (size_t)u.pm * 256 * lda; u.B = B + (size_t)u.pn * 256 * ldb; u.gl = nullptr; u.gn = 0; u.lda = lda; u.nt = nt; u.aux = 0; return true;
    }
};
struct SchedP1 { __device__ __forceinline__ void a_ready(const GU&, int) const {} __device__ __forceinline__ void done(const GU&, int) const {}
    const char* XN; const char* WIN; const char* WBt; const char* WPS; int G, c;
    __device__ __forceinline__ bool next(int i, GU& u) const {
        const int L = __builtin_amdgcn_readfirstlane(i * G + c); if (L >= 896 + 32) return false;
        u.gl = nullptr; u.gn = 0;
        if (L < 896) { g8::tile_of(L, 32, 28, u.pm, u.pn); u.A = XN + (size_t)u.pm * 256 * 4096; u.B = WIN + (size_t)u.pn * 256 * 4096; u.lda = 4096; u.nt = 32; u.aux = 0; return true; }
        const int J = L - 896, g = J >> 3; u.pm = J & 7; u.pn = 0; u.aux = 256 * g;
        u.A = WBt + (size_t)u.pm * 256 * 2048 + (size_t)g * 512; u.B = WPS + (size_t)g * PGD * PGD * 2; u.lda = 2048; u.nt = 4; return true;
    }
};
struct SchedW2 { __device__ __forceinline__ void a_ready(const GU&, int) const {} __device__ __forceinline__ void done(const GU&, int) const {}
    const char* WBt; const char* WPS; int G, c;
    __device__ __forceinline__ bool next(int i, GU& u) const {
        const int L = i * G + c; if (L >= 32) return false;
        const int g = L >> 3; u.pm = L & 7; u.pn = 0; u.aux = 256 * g;
        u.A = WBt + (size_t)u.pm * 256 * 2048 + (size_t)g * 512; u.B = WPS + (size_t)g * PGD * PGD * 2; u.gl = nullptr; u.gn = 0; u.lda = 2048; u.nt = 4; return true;
    }
};
struct SchedU { __device__ __forceinline__ void a_ready(const GU&, int) const {} __device__ __forceinline__ void done(const GU&, int) const {}
    const char* YD; const char* WA; const char* W2; int G, c;
    __device__ __forceinline__ bool next(int i, GU& u) const {
        const int L = (i >> 1) * G + c; if (L >= 256) return false;
        const int src = i & 1; g8::tile_of(L, 32, 8, u.pm, u.pn);
        u.A = YD + (size_t)u.pm * 256 * 4096 + src * 2048; u.B = (src ? W2 : WA) + (size_t)u.pn * 256 * 2048; u.gl = nullptr; u.gn = 0; u.lda = 4096; u.nt = 16; u.aux = src; return true;
    }
};
struct SchedMoeUp { __device__ __forceinline__ void a_ready(const GU&, int) const {} __device__ __forceinline__ void done(const GU&, int) const {}
    const char* X; const char* W; const int* list; const int* cnt; const volatile LAS int* ts; int G, c;
    __device__ __forceinline__ bool next(int i, GU& u) const {
        const int L = i * G + c; const int ntile = __builtin_amdgcn_readfirstlane(ts[16]); if (L >= 4 * ntile) return false;
        const int rt = L >> 2, pn = L & 3; int e = 0;
#pragma unroll
        for (int j = 1; j < 16; ++j) e += (rt >= ts[j]) ? 1 : 0;
        e = __builtin_amdgcn_readfirstlane(e);
        const int i0 = __builtin_amdgcn_readfirstlane(rt - ts[e]); int gn = __builtin_amdgcn_readfirstlane(cnt[e]) - 256 * i0; gn = gn > 256 ? 256 : gn;
        u.A = X; u.gl = list + e * T + 256 * i0; u.gn = gn; u.lda = 4096; u.B = W + ((size_t)e * 1024 + 256 * pn) * 4096; u.nt = 32; u.pm = rt; u.pn = pn; u.aux = e; return true;
    }
};
struct SchedE { __device__ __forceinline__ void a_ready(const GU&, int) const {} __device__ __forceinline__ void done(const GU&, int) const {}
    const char* PB; const char* WPP; int first, nfree, rank;
    __device__ __forceinline__ bool next(int i, GU& u) const {
        if (rank < 0) return false; const int L = rank + i * nfree; if (L >= 256) return false;
        g8::tile_of(L, 32, 8, u.pm, u.pn); u.A = PB + (size_t)u.pm * 256 * 512; u.B = WPP + (size_t)u.pn * 256 * 512; u.gl = nullptr; u.gn = 0; u.lda = 512; u.nt = 4; u.aux = 0; return true;
    }
};
struct SchedMoeDown { __device__ __forceinline__ void a_ready(const GU&, int) const {} __device__ __forceinline__ void done(const GU&, int) const {}
    const char* ACT; const char* W; const int* list; const int* cnt; const volatile LAS int* ts; int G, c;
    __device__ __forceinline__ bool next(int i, GU& u) const {
        const int L = i * G + c; const int ntile = __builtin_amdgcn_readfirstlane(ts[16]); if (L >= 8 * ntile) return false;
        const int rt = L >> 3, pn = L & 7; int e = 0;
#pragma unroll
        for (int j = 1; j < 16; ++j) e += (rt >= ts[j]) ? 1 : 0;
        e = __builtin_amdgcn_readfirstlane(e);
        const int i0 = __builtin_amdgcn_readfirstlane(rt - ts[e]); int gn = __builtin_amdgcn_readfirstlane(cnt[e]) - 256 * i0; gn = gn > 256 ? 256 : gn;
        u.A = ACT + (size_t)rt * 256 * 1024; u.gl = nullptr; u.gn = gn; u.lda = 1024; u.B = W + ((size_t)e * 2048 + 256 * pn) * 1024; u.nt = 8; u.pm = rt; u.pn = pn; u.aux = e * T + 256 * i0; return true;
    }
};

#define EPI_ROWS_BEGIN  _Pragma("unroll") for (int ai = 0; ai < 2; ++ai) _Pragma("unroll") for (int m = 0; m < 4; ++m) { const int r = ai * 128 + wr * 64 + m * 16 + fr;
#define EPI_ROWS_END    asm volatile("" ::: "memory"); }
struct EpiPlain {
    bf16* O; int ldc;
    __device__ __forceinline__ void operator()(const f32x4 (&acc)[2][2][4][2], const GU& u, int wr, int wc, int fr, int fq) const {
        const int col0 = u.pn * 256 + u.aux + wc * 32 + 8 * fq;
        EPI_ROWS_BEGIN
            bf16* rowp = O + (size_t)(u.pm * 256 + r) * ldc + col0;
#pragma unroll
            for (int bj = 0; bj < 2; ++bj) { const f32x4 v0 = acc[ai][bj][m][0], v1 = acc[ai][bj][m][1];
                u32x4 w; w.x = g8::cvt_pk_bf16(v0[0], v0[1]); w.y = g8::cvt_pk_bf16(v0[2], v0[3]); w.z = g8::cvt_pk_bf16(v1[0], v1[1]); w.w = g8::cvt_pk_bf16(v1[2], v1[3]);
                *(u32x4*)(rowp + bj * 128) = w; }
        EPI_ROWS_END
    }
};
struct EpiZ {
    bf16* Z;
    __device__ __forceinline__ void operator()(const f32x4 (&acc)[2][2][4][2], const GU& u, int wr, int wc, int fr, int fq) const {
        const int col0 = u.pn * 256 + wc * 32 + 8 * fq; const int kind = (u.pn >= 12) ? 2 : ((u.pn >= 4 && u.pn < 8) ? 1 : 0);
        EPI_ROWS_BEGIN
            bf16* rowp = Z + (size_t)(u.pm * 256 + r) * IN_COLS + col0;
#pragma unroll
            for (int bj = 0; bj < 2; ++bj) { f32x4 v0 = acc[ai][bj][m][0], v1 = acc[ai][bj][m][1];
                if (kind == 1) {
#pragma unroll
                    for (int j = 0; j < 4; ++j) { v0[j] = gelu_tanh(v0[j]); v1[j] = gelu_tanh(v1[j]); } }
                else if (kind == 2) {
#pragma unroll
                    for (int j = 0; j < 4; ++j) { v0[j] = fsigmoid(v0[j]); v1[j] = fsigmoid(v1[j]); } }
                u32x4 w; w.x = g8::cvt_pk_bf16(v0[0], v0[1]); w.y = g8::cvt_pk_bf16(v0[2], v0[3]); w.z = g8::cvt_pk_bf16(v1[0], v1[1]); w.w = g8::cvt_pk_bf16(v1[2], v1[3]);
                *(u32x4*)(rowp + bj * 128) = w; }
        EPI_ROWS_END
    }
};
struct EpiP1 { EpiZ z; EpiPlain w2;
    __device__ __forceinline__ void operator()(const f32x4 (&acc)[2][2][4][2], const GU& u, int wr, int wc, int fr, int fq) const { if (u.nt == 4) w2(acc, u, wr, wc, fr, fq); else z(acc, u, wr, wc, fr, fq); }
};
__device__ __forceinline__ void unpack8(const u32x4 w, float (&f)[8]) { f[0] = bflo(w.x); f[1] = bfhi(w.x); f[2] = bflo(w.y); f[3] = bfhi(w.y); f[4] = bflo(w.z); f[5] = bfhi(w.z); f[6] = bflo(w.w); f[7] = bfhi(w.w); }
struct EpiU {
    bf16* U; const bf16* Z;
    __device__ __forceinline__ void operator()(const f32x4 (&acc)[2][2][4][2], const GU& u, int wr, int wc, int fr, int fq) const {
        const int col0 = u.pn * 256 + wc * 32 + 8 * fq; const int gcol = (u.aux ? 5120 : 3072) + col0;
        EPI_ROWS_BEGIN
            const size_t row = (size_t)(u.pm * 256 + r);
#pragma unroll
            for (int bj = 0; bj < 2; ++bj) {
                float g[8], p[8]; unpack8(*(const u32x4*)(Z + row * IN_COLS + gcol + bj * 128), g);
                const f32x4 v0 = acc[ai][bj][m][0], v1 = acc[ai][bj][m][1];
                float o[8];
#pragma unroll
                for (int j = 0; j < 4; ++j) { o[j] = v0[j] * g[j]; o[4 + j] = v1[j] * g[4 + j]; }
                bf16* up = U + row * D + col0 + bj * 128;
                if (u.aux) { unpack8(*(const u32x4*)up, p);
#pragma unroll
                    for (int j = 0; j < 8; ++j) o[j] += p[j]; }
                u32x4 w; w.x = g8::cvt_pk_bf16(o[0], o[1]); w.y = g8::cvt_pk_bf16(o[2], o[3]); w.z = g8::cvt_pk_bf16(o[4], o[5]); w.w = g8::cvt_pk_bf16(o[6], o[7]);
                *(u32x4*)up = w; }
        EPI_ROWS_END
    }
};
struct EpiX1 {
    const float* x; bf16* X1B;
    __device__ __forceinline__ void operator()(const f32x4 (&acc)[2][2][4][2], const GU& u, int wr, int wc, int fr, int fq) const {
        const int col0 = u.pn * 256 + wc * 32 + 8 * fq;
        EPI_ROWS_BEGIN
            const size_t off = (size_t)(u.pm * 256 + r) * D + col0;
#pragma unroll
            for (int bj = 0; bj < 2; ++bj) {
                const f32x4 a0 = *(const f32x4*)(x + off + bj * 128), a1 = *(const f32x4*)(x + off + bj * 128 + 4);
                const f32x4 v0 = acc[ai][bj][m][0] + a0, v1 = acc[ai][bj][m][1] + a1;
                u32x4 w; w.x = g8::cvt_pk_bf16(v0[0], v0[1]); w.y = g8::cvt_pk_bf16(v0[2], v0[3]); w.z = g8::cvt_pk_bf16(v1[0], v1[1]); w.w = g8::cvt_pk_bf16(v1[2], v1[3]);
                *(u32x4*)(X1B + off + bj * 128) = w; }
        EPI_ROWS_END
    }
};
struct EpiAct {
    bf16* ACT; const float* rstd2;
    __device__ __forceinline__ void operator()(const f32x4 (&acc)[2][2][4][2], const GU& u, int wr, int wc, int fr, int fq) const {
        const int col0 = u.pn * 128 + wc * 32 + 8 * fq;
        EPI_ROWS_BEGIN
            int tok = 0; if (r < u.gn) tok = u.gl[r] >> 1;
            const float rs = rstd2[tok];
            const f32x4 g0 = acc[ai][0][m][0] * rs, g1 = acc[ai][0][m][1] * rs, u0 = acc[ai][1][m][0] * rs, u1 = acc[ai][1][m][1] * rs;
            float o[8];
#pragma unroll
            for (int j = 0; j < 4; ++j) { o[j] = g0[j] * fsigmoid(g0[j]) * u0[j]; o[4 + j] = g1[j] * fsigmoid(g1[j]) * u1[j]; }
            u32x4 w; w.x = g8::cvt_pk_bf16(o[0], o[1]); w.y = g8::cvt_pk_bf16(o[2], o[3]); w.z = g8::cvt_pk_bf16(o[4], o[5]); w.w = g8::cvt_pk_bf16(o[6], o[7]);
            *(u32x4*)(ACT + (size_t)(u.pm * 256 + r) * DE + col0) = w;
        EPI_ROWS_END
    }
};
struct EpiDown {
    bf16* YS; const int* list; const float* wl;
    __device__ __forceinline__ void operator()(const f32x4 (&acc)[2][2][4][2], const GU& u, int wr, int wc, int fr, int fq) const {
        const int col0 = u.pn * 256 + wc * 32 + 8 * fq;
        EPI_ROWS_BEGIN
            if (r < u.gn) {
                const int ent = list[u.aux + r]; const float w8 = wl[u.aux + r];
                bf16* rowp = YS + ((size_t)(ent & 1) * T + (size_t)(ent >> 1)) * D + col0;
#pragma unroll
                for (int bj = 0; bj < 2; ++bj) { const f32x4 v0 = acc[ai][bj][m][0] * w8, v1 = acc[ai][bj][m][1] * w8;
                    u32x4 w; w.x = g8::cvt_pk_bf16(v0[0], v0[1]); w.y = g8::cvt_pk_bf16(v0[2], v0[3]); w.z = g8::cvt_pk_bf16(v1[0], v1[1]); w.w = g8::cvt_pk_bf16(v1[2], v1[3]);
                    *(u32x4*)(rowp + bj * 128) = w; }
            }
        EPI_ROWS_END
    }
};
struct EpiPle {
    float* X3; const bf16* X2B; const bf16* E; const float* rstdp;
    __device__ __forceinline__ void operator()(const f32x4 (&acc)[2][2][4][2], const GU& u, int wr, int wc, int fr, int fq) const {
        const int col0 = u.pn * 256 + wc * 32 + 8 * fq;
        EPI_ROWS_BEGIN
            const size_t row = (size_t)(u.pm * 256 + r), off = row * D + col0; const float rs = rstdp[row];
#pragma unroll
            for (int bj = 0; bj < 2; ++bj) {
                float x2[8], e[8]; unpack8(*(const u32x4*)(X2B + off + bj * 128), x2); unpack8(*(const u32x4*)(E + off + bj * 128), e);
                const f32x4 v0 = acc[ai][bj][m][0] * rs, v1 = acc[ai][bj][m][1] * rs; f32x4 o0, o1;
#pragma unroll
                for (int j = 0; j < 4; ++j) { o0[j] = x2[j] + fsigmoid(v0[j]) * e[j]; o1[j] = x2[4 + j] + fsigmoid(v1[j]) * e[4 + j]; }
                *(f32x4*)(X3 + off + bj * 128) = o0; *(f32x4*)(X3 + off + bj * 128 + 4) = o1; }
        EPI_ROWS_END
    }
};


constexpr int CW_DONE = 8192;
struct SchedMoe {
    const char* wsb; const volatile LAS int* ts;
    int G, c, nup, nupc, nfree, rank, nE;
    __device__ __forceinline__ void init(int G_, int c_, int ntile) {
        G = G_; c = c_; nup = 4 * ntile; nupc = (nup > c) ? (nup - c + G - 1) / G : 0;
        int n2 = nup - G; n2 = n2 < 0 ? 0 : (n2 > G ? G : n2); nfree = G - n2; rank = c - n2; if (nfree <= 0) { nfree = G; rank = c; }
        nE = (rank >= 0 && rank < 256) ? (256 - rank + nfree - 1) / nfree : 0;
    }
    __device__ __forceinline__ void expert_of(int rt, int& e, int& i0, int& gn) const {
        e = 0;
#pragma unroll
        for (int j = 1; j < 16; ++j) e += (rt >= ts[j]) ? 1 : 0;
        e = __builtin_amdgcn_readfirstlane(e); i0 = __builtin_amdgcn_readfirstlane(rt - ts[e]); gn = __builtin_amdgcn_readfirstlane(((const int*)(wsb + WS_CTL))[CW_CNT + e]) - 256 * i0; gn = gn > 256 ? 256 : gn;
    }
    __device__ __forceinline__ bool next(int i, GU& u) const {
        const char* X = wsb + WS_YD; const char* WGU = wsb + WS_WGU; const char* ACT = wsb + WS_ACT; const char* WD = wsb + WS_WD; const char* PB = wsb + WS_PB; const char* WPP = wsb + WS_WPP; const int* list = (const int*)(wsb + WS_LIST);
        if (i < nupc) { const int L = i * G + c, rt = L >> 2, pn = L & 3; int e, i0, gn; expert_of(rt, e, i0, gn);
            u.A = X; u.gl = list + e * T + 256 * i0; u.gn = gn; u.lda = 4096; u.B = WGU + ((size_t)e * 1024 + 256 * pn) * 4096; u.nt = 32; u.pm = rt; u.pn = pn; u.aux = e; return true; }
        if (rank < 0) return false;
        int j = i - nupc;
        if (j < nE) { const int L = rank + j * nfree; g8::tile_of(L, 32, 8, u.pm, u.pn); u.A = PB + (size_t)u.pm * 256 * 512; u.B = WPP + (size_t)u.pn * 256 * 512; u.gl = nullptr; u.gn = 0; u.lda = 512; u.nt = 4; u.aux = 0; return true; }
        j -= nE; const int L = rank + j * nfree; if (L >= 2 * nup) return false;
        const int rt = L >> 3, pn = L & 7; int e, i0, gn; expert_of(rt, e, i0, gn);
        u.A = ACT + (size_t)rt * 256 * 1024; u.gl = nullptr; u.gn = gn; u.lda = 1024; u.B = WD + ((size_t)e * 2048 + 256 * pn) * 1024; u.nt = 8; u.pm = rt; u.pn = pn; u.aux = e * T + 256 * i0; return true;
    }
    __device__ __forceinline__ void a_ready(const GU& u, int wid) const {
        if (u.nt != 8) return;
        if (wid == 0) {
            unsigned* w = (unsigned*)(wsb + WS_CTL) + CW_DONE + 64 * u.pm; unsigned sp = 0;
            while ((unsigned)__builtin_amdgcn_readfirstlane(__hip_atomic_load(w, RLX_AGENT)) < 32u) { __builtin_amdgcn_s_sleep(2); if (++sp > (1u << 22)) break; }
            __builtin_amdgcn_fence(__ATOMIC_ACQUIRE, "agent");
            asm volatile("s_waitcnt vmcnt(0)" ::: "memory");
        }
        asm volatile("" ::: "memory"); __builtin_amdgcn_s_barrier(); asm volatile("" ::: "memory");
    }
    __device__ __forceinline__ void done(const GU& u, int lane) const {
        if (u.nt != 32) return;
        asm volatile("s_waitcnt vmcnt(0)" ::: "memory");
        if (lane == 0) __hip_atomic_fetch_add((unsigned*)(wsb + WS_CTL) + CW_DONE + 64 * u.pm, 1u, RLX_AGENT);
    }
};
struct EpiMoe {
    unsigned char* wsb;
    __device__ __forceinline__ void operator()(const f32x4 (&acc)[2][2][4][2], const GU& u, int wr, int wc, int fr, int fq) const {
        bf16* ACT = (bf16*)(wsb + WS_ACT); const float* rstd2 = (const float*)(wsb + WS_MISC + MI_RSTD2); bf16* YS = (bf16*)(wsb + WS_YS); const int* list = (const int*)(wsb + WS_LIST); const float* wl = (const float*)(wsb + WS_WL); bf16* Eo = (bf16*)(wsb + WS_XN);
        if (u.nt == 32) {
            const __amdgpu_buffer_rsrc_t rs_ = __builtin_amdgcn_make_buffer_rsrc(ACT, 0, (int)((2 * T + 4096) * DE * 2), 0x00020000);
            const int col0 = u.pn * 128 + wc * 32 + 8 * fq;
            EPI_ROWS_BEGIN
                int tok = 0; if (r < u.gn) tok = u.gl[r] >> 1;
                const float rs = rstd2[tok];
                const f32x4 g0 = acc[ai][0][m][0] * rs, g1 = acc[ai][0][m][1] * rs, u0 = acc[ai][1][m][0] * rs, u1 = acc[ai][1][m][1] * rs;
                float o[8];
#pragma unroll
                for (int j = 0; j < 4; ++j) { o[j] = g0[j] * fsigmoid(g0[j]) * u0[j]; o[4 + j] = g1[j] * fsigmoid(g1[j]) * u1[j]; }
                u32x4 w; w.x = g8::cvt_pk_bf16(o[0], o[1]); w.y = g8::cvt_pk_bf16(o[2], o[3]); w.z = g8::cvt_pk_bf16(o[4], o[5]); w.w = g8::cvt_pk_bf16(o[6], o[7]);
                __builtin_amdgcn_raw_buffer_store_b128(w, rs_, (unsigned)(((size_t)(u.pm * 256 + r) * DE + col0) * 2), 0, 16);
            EPI_ROWS_END
        } else if (u.nt == 8) {
            const int col0 = u.pn * 256 + wc * 32 + 8 * fq;
            EPI_ROWS_BEGIN
                if (r < u.gn) {
                    const int ent = list[u.aux + r]; const float w8 = wl[u.aux + r];
                    bf16* rowp = YS + ((size_t)(ent & 1) * T + (size_t)(ent >> 1)) * D + col0;
#pragma unroll
                    for (int bj = 0; bj < 2; ++bj) { const f32x4 v0 = acc[ai][bj][m][0] * w8, v1 = acc[ai][bj][m][1] * w8;
                        u32x4 w; w.x = g8::cvt_pk_bf16(v0[0], v0[1]); w.y = g8::cvt_pk_bf16(v0[2], v0[3]); w.z = g8::cvt_pk_bf16(v1[0], v1[1]); w.w = g8::cvt_pk_bf16(v1[2], v1[3]);
                        *(u32x4*)(rowp + bj * 128) = w; }
                }
            EPI_ROWS_END
        } else {
            const int col0 = u.pn * 256 + wc * 32 + 8 * fq;
            EPI_ROWS_BEGIN
                bf16* rowp = Eo + (size_t)(u.pm * 256 + r) * D + col0;
#pragma unroll
                for (int bj = 0; bj < 2; ++bj) { const f32x4 v0 = acc[ai][bj][m][0], v1 = acc[ai][bj][m][1];
                    u32x4 w; w.x = g8::cvt_pk_bf16(v0[0], v0[1]); w.y = g8::cvt_pk_bf16(v0[2], v0[3]); w.z = g8::cvt_pk_bf16(v1[0], v1[1]); w.w = g8::cvt_pk_bf16(v1[2], v1[3]);
                    *(u32x4*)(rowp + bj * 128) = w; }
            EPI_ROWS_END
        }
    }
};

constexpr int P2_BFR = 0, P2_CST = 24576, P2_WT = 26624, P2_HS = 30720, P2_IO = 32768, P2_IOW = 9216, P2_ROW = 144;
__device__ __forceinline__ float neg_expm1(float x) {
    const float p = x * (1.0f + x * (0.5f + x * (0.16666667f + x * (0.041666668f + x * (0.0083333338f + x * 0.0013888889f)))));
    const float q = 1.0f - __expf(x);
    return (x > -0.25f) ? -p : q;
}
__device__ __forceinline__ void p2_lru_item(Frame& F, unsigned char* ws, int item) {
    const bf16* Z = (const bf16*)(ws + WS_Z); bf16* YD = (bf16*)(ws + WS_YD);
    const int lane = F.lane, wave = F.wave, tid = F.tid, fr = lane & 15, fq = lane >> 4;
    const int c = item >> 6, bh = item & 63, b = bh >> 4, h = bh & 15;
    const int tw = b * SEQ + c * 256 + 32 * wave, sw = c * 256 + 32 * wave;
    LAS unsigned char* L = F.lds;
    __syncthreads();
    {
        const u32x4* src = (const u32x4*)(ws + WS_MISC + MI_WRG) + (size_t)h * 24 * 64;
#pragma unroll
        for (int k = 0; k < 3; ++k) *(LAS u32x4*)(L + P2_BFR + (tid + 512 * k) * 16) = src[tid + 512 * k];
        if (tid < 128) *(LAS u32x4*)(L + P2_CST + tid * 16) = ((const u32x4*)(ws + WS_MISC + MI_CST) + (size_t)h * 128)[tid];
    }
    LAS unsigned char* GG = L + P2_IO + wave * P2_IOW; LAS unsigned char* YT = GG + 32 * P2_ROW;
#pragma unroll
    for (int k = 0; k < 4; ++k) { const int p = lane + 64 * k, row = p >> 3, c8 = p & 7;
        *(LAS u32x4*)(GG + row * P2_ROW + c8 * 16) = *(const u32x4*)(Z + (size_t)(tw + row) * IN_COLS + 1024 + 64 * h + 8 * c8); }
    __syncthreads();
    const LAS float* CS = (const LAS float*)(L + P2_CST);
    float ba4[4], bx4[4], sp4[4];
#pragma unroll
    for (int n = 0; n < 4; ++n) { ba4[n] = CS[5 * 64 + 16 * n + fr]; bx4[n] = CS[6 * 64 + 16 * n + fr]; sp4[n] = CS[7 * 64 + 16 * n + fr]; }
    float cA[4] = {1.f, 1.f, 1.f, 1.f}, cH[4] = {0.f, 0.f, 0.f, 0.f};
    float Ac[2][4][4], Hl[2][4][4];
#pragma unroll
    for (int rt = 0; rt < 2; ++rt) {
        bf16x8 af[2];
#pragma unroll
        for (int sx = 0; sx < 2; ++sx) {
            const int k0 = 32 * sx + 8 * fq; float xa[8];
            { const f32x4 c0 = *(const LAS f32x4*)(CS + 4 * 64 + k0), c1 = *(const LAS f32x4*)(CS + 4 * 64 + k0 + 4);
#pragma unroll
              for (int j = 0; j < 4; ++j) { xa[j] = c0[j]; xa[4 + j] = c1[j]; } }
#pragma unroll
            for (int q = 0; q < 4; ++q) {
                const int dpos = 16 * rt + fr + q - 3; const bool ok = (sw + dpos) >= 0; const int drow = ok ? dpos : 0;
                float xv[8]; unpack8(*(const u32x4*)(Z + (size_t)(tw + drow) * IN_COLS + 64 * h + k0), xv);
                const f32x4 w0 = *(const LAS f32x4*)(CS + q * 64 + k0), w1 = *(const LAS f32x4*)(CS + q * 64 + k0 + 4); const float mk = ok ? 1.f : 0.f;
#pragma unroll
                for (int j = 0; j < 4; ++j) { xa[j] += w0[j] * (xv[j] * mk); xa[4 + j] += w1[j] * (xv[4 + j] * mk); }
            }
            u32x4 pk; pk.x = pk2(xa[0], xa[1]); pk.y = pk2(xa[2], xa[3]); pk.z = pk2(xa[4], xa[5]); pk.w = pk2(xa[6], xa[7]);
            af[sx] = __builtin_bit_cast(bf16x8, pk);
            __builtin_amdgcn_sched_barrier(0);
        }
        __builtin_amdgcn_sched_barrier(0);
#pragma unroll
        for (int n = 0; n < 4; ++n) {
            f32x4 Dm[3];
#pragma unroll
            for (int q = 0; q < 3; ++q) { Dm[q] = (f32x4){0.f, 0.f, 0.f, 0.f};
#pragma unroll
                for (int sx = 0; sx < 2; ++sx) { const bf16x8 bfr = *(const LAS bf16x8*)(L + P2_BFR + ((4 * q + n) * 2 + sx) * 1024 + lane * 16); Dm[q] = __builtin_amdgcn_mfma_f32_16x16x32_bf16(af[sx], bfr, Dm[q], 0, 0, 0); } }
            float a[4], hh[4];
#pragma unroll
            for (int i = 0; i < 4; ++i) {
                const float r = fsigmoid(Dm[0][i] + ba4[n]), ig = fsigmoid(Dm[1][i] + bx4[n]), xv = Dm[2][i];
                const float la = -r * sp4[n];
                a[i] = __expf(la); hh[i] = sqrtf(neg_expm1(2.0f * la)) * ig * xv;
            }
#pragma unroll
            for (int i = 1; i < 4; ++i) { hh[i] = a[i] * hh[i - 1] + hh[i]; a[i] = a[i] * a[i - 1]; }
            float XA = a[3], XH = hh[3];
            { const float pa = __shfl_up(XA, 16), ph = __shfl_up(XH, 16); if (fq >= 1) { XH = XA * ph + XH; XA = XA * pa; } }
            { const float pa = __shfl_up(XA, 32), ph = __shfl_up(XH, 32); if (fq >= 2) { XH = XA * ph + XH; XA = XA * pa; } }
            float EA = __shfl_up(XA, 16), EH = __shfl_up(XH, 16); if (fq == 0) { EA = 1.f; EH = 0.f; }
            const float TA = __shfl(XA, 48 + fr), TH = __shfl(XH, 48 + fr);
            const float PA = cA[n] * EA, PH = EA * cH[n] + EH;
#pragma unroll
            for (int i = 0; i < 4; ++i) { Ac[rt][n][i] = PA * a[i]; Hl[rt][n][i] = a[i] * PH + hh[i]; }
            cH[n] = TA * cH[n] + TH; cA[n] = cA[n] * TA;
            __builtin_amdgcn_sched_barrier(0);
        }
    }
    if (fq == 0) {
#pragma unroll
        for (int n = 0; n < 4; ++n) *(LAS f32x2*)(L + P2_WT + (wave * 64 + 16 * n + fr) * 8) = (f32x2){cA[n], cH[n]};
    }
    __syncthreads();
    if (wave == 0) {
        unsigned long long* GR = (unsigned long long*)(ws + WS_CTL + CTL_GRAN);
        float hin = 0.f;
        if (c > 0) {
            unsigned long long* g = GR + ((size_t)(bh * 8 + c - 1) * 64 + lane); unsigned sp = 0; unsigned long long v;
            for (;;) { v = __hip_atomic_load(g, RLX_AGENT); if (__all((unsigned)(v >> 32) == 1u)) break; __builtin_amdgcn_s_sleep(1); if (++sp > (1u << 22)) break; }
            hin = __builtin_bit_cast(float, (unsigned)v);
        }
        float hcur = hin;
#pragma unroll
        for (int w = 0; w < 8; ++w) { *(LAS float*)(L + P2_HS + (w * 64 + lane) * 4) = hcur; const f32x2 t = *(const LAS f32x2*)(L + P2_WT + (w * 64 + lane) * 8); hcur = t.x * hcur + t.y; }
        __hip_atomic_store(GR + ((size_t)(bh * 8 + c) * 64 + lane), (1ull << 32) | (unsigned long long)__builtin_bit_cast(unsigned, hcur), RLX_AGENT);
    }
    __syncthreads();
    float hs[4];
#pragma unroll
    for (int n = 0; n < 4; ++n) hs[n] = *(const LAS float*)(L + P2_HS + (wave * 64 + 16 * n + fr) * 4);
#pragma unroll
    for (int rt = 0; rt < 2; ++rt)
#pragma unroll
        for (int n = 0; n < 4; ++n)
#pragma unroll
            for (int i = 0; i < 4; ++i) { const int row = 16 * rt + 4 * fq + i, col = 16 * n + fr;
                const float g = bf2f(*(const LAS unsigned short*)(GG + row * P2_ROW + col * 2));
                *(LAS unsigned short*)(YT + row * P2_ROW + col * 2) = (unsigned short)f2bf((Hl[rt][n][i] + Ac[rt][n][i] * hs[n]) * g); }
    LDS_WAIT();
#pragma unroll
    for (int k = 0; k < 4; ++k) { const int p = lane + 64 * k, row = p >> 3, c8 = p & 7;
        *(u32x4*)(YD + (size_t)(tw + row) * D + 64 * h + 8 * c8) = *(const LAS u32x4*)(YT + row * P2_ROW + c8 * 16); }
}
__device__ __forceinline__ void p2_pool_item(Frame& F, unsigned char* ws, int blk) {
    const bf16* Z = (const bf16*)(ws + WS_Z); bf16* YD = (bf16*)(ws + WS_YD);
    const int tid = F.tid, g = (2 * tid) >> 8, w = 2 << g, tb = blk * 64, s0p = tb % SEQ;
    const unsigned* zc = (const unsigned*)(Z + 2048 + 2 * tid);
    float s0 = 0.f, s1 = 0.f;
    for (int k = 1; k <= w; ++k) if (s0p - k >= 0) { const unsigned v = zc[(size_t)(tb - k) * (IN_COLS / 2)]; s0 += bflo(v); s1 += bfhi(v); }
    for (int tt = 0; tt < 64; ++tt) {
        const unsigned v = zc[(size_t)(tb + tt) * (IN_COLS / 2)]; const float x0 = bflo(v), x1 = bfhi(v); s0 += x0; s1 += x1;
        const int pos = s0p + tt; if (pos - w >= 0) { const unsigned vo = zc[(size_t)(tb + tt - w) * (IN_COLS / 2)]; s0 -= bflo(vo); s1 -= bfhi(vo); }
        const float inv = 1.0f / (float)((pos + 1) < w ? (pos + 1) : w);
        *(unsigned*)(YD + (size_t)(tb + tt) * D + 1024 + 2 * tid) = pk2(s0 * inv - x0, s1 * inv - x1);
    }
}
__device__ __forceinline__ void p2_fast(Frame& F) {
    unsigned char* ws = WSP;
    for (int item = (int)blockIdx.x; item < 512 + 128; item += F.G) { if (item < 512) p2_lru_item(F, ws, item); else p2_pool_item(F, ws, item - 512); }
}

__device__ __forceinline__ void p5_router(Frame& F) {
    unsigned char* ws = WSP; const float* X1 = OUTP; const float* g2 = INP(16); const float* wg = INP(17); const float* bg = INP(18); const float* we = INP(19); const float* be = INP(20);
    float* rstd2 = (float*)(ws + WS_MISC + MI_RSTD2); int* list = (int*)(ws + WS_LIST); float* wl = (float*)(ws + WS_WL); unsigned* cnt = (unsigned*)(ws + WS_CTL) + CW_CNT;
    const int gw = F.vcu * NWAVES + F.wave, NGW = F.G * NWAVES;
    for (int t = gw; t < T; t += NGW) {
        const f32x4* xr = (const f32x4*)(X1 + (size_t)t * D) + F.lane; const f32x4* gr = (const f32x4*)g2 + F.lane;
        f32x4 v[8]; float s = 0.f;
#pragma unroll
        for (int j = 0; j < 8; ++j) { v[j] = xr[64 * j]; s += (v[j].x * v[j].x + v[j].y * v[j].y) + (v[j].z * v[j].z + v[j].w * v[j].w); }
        const float rstd = 1.f / sqrtf(wave_sum(s) * (1.f / D) + EPS);
        float lg[4] = {0.f, 0.f, 0.f, 0.f}, le[16];
#pragma unroll
        for (int j = 0; j < 16; ++j) le[j] = 0.f;
#pragma unroll
        for (int j = 0; j < 8; ++j) { const f32x4 g = gr[64 * j]; const int k0 = 4 * (F.lane + 64 * j);
#pragma unroll
            for (int q = 0; q < 4; ++q) { const float hv = v[j][q] * rstd * g[q]; const f32x4 w4 = *(const f32x4*)(wg + (size_t)(k0 + q) * 4);
#pragma unroll
                for (int c = 0; c < 4; ++c) lg[c] += hv * w4[c];
#pragma unroll
                for (int c4 = 0; c4 < 4; ++c4) { const f32x4 w16 = *(const f32x4*)(we + (size_t)(k0 + q) * 16 + 4 * c4);
#pragma unroll
                    for (int c = 0; c < 4; ++c) le[4 * c4 + c] += hv * w16[c]; } } }
#pragma unroll
        for (int j = 0; j < 4; ++j) lg[j] = wave_sum(lg[j]) + bg[j];
#pragma unroll
        for (int j = 0; j < 16; ++j) le[j] = wave_sum(le[j]) + be[j];
        if (F.lane == 0) {
            int gi = 0; float gm = lg[0];
#pragma unroll
            for (int j = 1; j < 4; ++j) if (lg[j] > gm) { gm = lg[j]; gi = j; }
            float gs = 0.f;
#pragma unroll
            for (int j = 0; j < 4; ++j) gs += expf(lg[j] - gm);
            const float g_w = 1.f / gs;
            float ls[4];
#pragma unroll
            for (int j = 0; j < 4; ++j) { float vv = le[j];
#pragma unroll
                for (int g = 1; g < 4; ++g) if (gi == g) vv = le[g * 4 + j];
                ls[j] = vv; }
            float mx = ls[0];
#pragma unroll
            for (int j = 1; j < 4; ++j) mx = fmaxf(mx, ls[j]);
            float pe[4], ps = 0.f;
#pragma unroll
            for (int j = 0; j < 4; ++j) { pe[j] = expf(ls[j] - mx); ps += pe[j]; }
#pragma unroll
            for (int j = 0; j < 4; ++j) pe[j] /= ps;
            float v0 = -1.f; int i0 = 0;
#pragma unroll
            for (int j = 0; j < 4; ++j) if (pe[j] > v0) { v0 = pe[j]; i0 = j; }
            float v1 = -1.f; int i1 = 0;
#pragma unroll
            for (int j = 0; j < 4; ++j) if (j != i0 && pe[j] > v1) { v1 = pe[j]; i1 = j; }
            const float sv = v0 + v1; const int e0 = gi * 4 + i0, e1 = gi * 4 + i1;
            rstd2[t] = rstd;
            const unsigned p0 = __hip_atomic_fetch_add(cnt + e0, 1u, RLX_AGENT), p1 = __hip_atomic_fetch_add(cnt + e1, 1u, RLX_AGENT);
            list[e0 * T + p0] = t * 2; wl[e0 * T + p0] = g_w * v0 / sv; list[e1 * T + p1] = t * 2 + 1; wl[e1 * T + p1] = g_w * v1 / sv;
        }
    }
}

constexpr int P5_PL = 0, P5_SS = 32768, P5_LG = 36864, P5_RS = 40960;
__device__ __forceinline__ void p5_fast(Frame& F) {
    unsigned char* ws = WSP; const bf16* X1B = (const bf16*)(ws + WS_YD); const float* bg = INP(18); const float* be = INP(20);
    float* rstd2 = (float*)(ws + WS_MISC + MI_RSTD2); int* list = (int*)(ws + WS_LIST); float* wl = (float*)(ws + WS_WL); unsigned* cnt = (unsigned*)(ws + WS_CTL) + CW_CNT;
    const u32x4* WRT = (const u32x4*)(ws + WS_MISC + MI_WRT);
    const int lane = F.lane, wave = F.wave, tid = F.tid, fr = lane & 15, fq = lane >> 4; LAS unsigned char* L = F.lds;
    for (int item = (int)blockIdx.x; item < T / 32; item += F.G) {
        const int r0 = item * 32;
        f32x4 acc[2][2]; float ss[2] = {0.f, 0.f};
#pragma unroll
        for (int rt = 0; rt < 2; ++rt)
#pragma unroll
            for (int nt = 0; nt < 2; ++nt) acc[rt][nt] = (f32x4){0.f, 0.f, 0.f, 0.f};
#pragma unroll 2
        for (int kk = 0; kk < 8; ++kk) {
            const int ks = wave * 8 + kk;
            bf16x8 bh[2], bl[2];
#pragma unroll
            for (int nt = 0; nt < 2; ++nt) { const u32x4* p = WRT + ((size_t)(ks * 2 + nt) * 2) * 64 + lane; bh[nt] = __builtin_bit_cast(bf16x8, p[0]); bl[nt] = __builtin_bit_cast(bf16x8, p[64]); }
#pragma unroll
            for (int rt = 0; rt < 2; ++rt) {
                const u32x4 xw = *(const u32x4*)(X1B + (size_t)(r0 + 16 * rt + fr) * D + 32 * ks + 8 * fq);
                float v[8]; unpack8(xw, v);
#pragma unroll
                for (int j = 0; j < 8; ++j) ss[rt] += v[j] * v[j];
                const bf16x8 ah = __builtin_bit_cast(bf16x8, xw);
#pragma unroll
                for (int nt = 0; nt < 2; ++nt) {
                    acc[rt][nt] = __builtin_amdgcn_mfma_f32_16x16x32_bf16(ah, bh[nt], acc[rt][nt], 0, 0, 0);
                    acc[rt][nt] = __builtin_amdgcn_mfma_f32_16x16x32_bf16(ah, bl[nt], acc[rt][nt], 0, 0, 0);
                }
            }
        }
        __syncthreads();
#pragma unroll
        for (int rt = 0; rt < 2; ++rt) {
#pragma unroll
            for (int nt = 0; nt < 2; ++nt)
#pragma unroll
                for (int i = 0; i < 4; ++i) *(LAS float*)(L + P5_PL + ((wave * 32 + 16 * rt + 4 * fq + i) * 32 + 16 * nt + fr) * 4) = acc[rt][nt][i];
            float s = ss[rt]; s += __shfl_xor(s, 16); s += __shfl_xor(s, 32);
            if (fq == 0) *(LAS float*)(L + P5_SS + (wave * 32 + 16 * rt + fr) * 4) = s;
        }
        __syncthreads();
        {
            const int row = tid >> 4, col = tid & 15; float a0 = 0.f, a1 = 0.f;
#pragma unroll
            for (int w = 0; w < 8; ++w) { a0 += *(const LAS float*)(L + P5_PL + ((w * 32 + row) * 32 + col) * 4); a1 += *(const LAS float*)(L + P5_PL + ((w * 32 + row) * 32 + col + 16) * 4); }
            *(LAS float*)(L + P5_LG + (row * 32 + col) * 4) = a0; *(LAS float*)(L + P5_LG + (row * 32 + col + 16) * 4) = a1;
            if (col == 0) { float s = 0.f;
#pragma unroll
                for (int w = 0; w < 8; ++w) s += *(const LAS float*)(L + P5_SS + (w * 32 + row) * 4);
                *(LAS float*)(L + P5_RS + row * 4) = 1.f / sqrtf(s * (1.f / D) + EPS); }
        }
        __syncthreads();
        if (tid < 32) {
            const int t = r0 + tid; const float rstd = *(const LAS float*)(L + P5_RS + tid * 4); const LAS float* lgp = (const LAS float*)(L + P5_LG + tid * 128);
            float lg[4], le[16];
#pragma unroll
            for (int j = 0; j < 4; ++j) lg[j] = lgp[j] * rstd + bg[j];
#pragma unroll
            for (int j = 0; j < 16; ++j) le[j] = lgp[4 + j] * rstd + be[j];
            int gi = 0; float gm = lg[0];
#pragma unroll
            for (int j = 1; j < 4; ++j) if (lg[j] > gm) { gm = lg[j]; gi = j; }
            float gs = 0.f;
#pragma unroll
            for (int j = 0; j < 4; ++j) gs += expf(lg[j] - gm);
            const float g_w = 1.f / gs;
            float ls[4];
#pragma unroll
            for (int j = 0; j < 4; ++j) { float vv = le[j];
#pragma unroll
                for (int g = 1; g < 4; ++g) if (gi == g) vv = le[g * 4 + j];
                ls[j] = vv; }
            float mx = ls[0];
#pragma unroll
            for (int j = 1; j < 4; ++j) mx = fmaxf(mx, ls[j]);
            float pe[4], ps = 0.f;
#pragma unroll
            for (int j = 0; j < 4; ++j) { pe[j] = expf(ls[j] - mx); ps += pe[j]; }
#pragma unroll
            for (int j = 0; j < 4; ++j) pe[j] /= ps;
            float v0 = -1.f; int i0 = 0;
#pragma unroll
            for (int j = 0; j < 4; ++j) if (pe[j] > v0) { v0 = pe[j]; i0 = j; }
            float v1 = -1.f; int i1 = 0;
#pragma unroll
            for (int j = 0; j < 4; ++j) if (j != i0 && pe[j] > v1) { v1 = pe[j]; i1 = j; }
            const float sv = v0 + v1; const int e0 = gi * 4 + i0, e1 = gi * 4 + i1;
            rstd2[t] = rstd;
            const unsigned p0 = __hip_atomic_fetch_add(cnt + e0, 1u, RLX_AGENT), p1 = __hip_atomic_fetch_add(cnt + e1, 1u, RLX_AGENT);
            list[e0 * T + p0] = t * 2; wl[e0 * T + p0] = g_w * v0 / sv; list[e1 * T + p1] = t * 2 + 1; wl[e1 * T + p1] = g_w * v1 / sv;
        }
    }
}
__device__ __forceinline__ void moe_table(Frame& F, volatile LAS int* ts) {
    if (F.tid == 0) { unsigned* ctl = (unsigned*)(WSP + WS_CTL); int s = 0; for (int e = 0; e < NE; ++e) { ts[e] = s; s += ((int)__hip_atomic_load(ctl + CW_CNT + e, RLX_AGENT) + 255) >> 8; } ts[16] = s; }
    __syncthreads();
}
__device__ __forceinline__ void p8_combine(Frame& F) {
    unsigned char* ws = WSP; const bf16* YS = (const bf16*)(ws + WS_YS); bf16* XB = (bf16*)(ws + WS_YD); float* rstdp = (float*)(ws + WS_MISC + MI_RSTDP);
    const int gw = F.vcu * NWAVES + F.wave, NGW = F.G * NWAVES;
    for (int t = gw; t < T; t += NGW) {
        u32x4* xr = (u32x4*)(XB + (size_t)t * D) + F.lane; const u32x4* y0 = (const u32x4*)(YS + (size_t)t * D) + F.lane; const u32x4* y1 = (const u32x4*)(YS + (size_t)(T + t) * D) + F.lane;
        float s = 0.f;
#pragma unroll
        for (int j = 0; j < 4; ++j) { float a[8], b[8], c[8]; unpack8(xr[64 * j], a); unpack8(y0[64 * j], b); unpack8(y1[64 * j], c);
#pragma unroll
            for (int q = 0; q < 8; ++q) { a[q] += b[q] + c[q]; a[q] = bf2f(f2bf(a[q])); s += a[q] * a[q]; }
            u32x4 o; o.x = pk2(a[0], a[1]); o.y = pk2(a[2], a[3]); o.z = pk2(a[4], a[5]); o.w = pk2(a[6], a[7]); xr[64 * j] = o; }
        s = wave_sum(s);
        if (F.lane == 0) rstdp[t] = 1.f / sqrtf(s * (1.f / D) + EPS);
    }
}
__device__ __forceinline__ void p10_final(Frame& F) {
    const int gw = F.vcu * NWAVES + F.wave, NGW = F.G * NWAVES; float* outp = OUTP; const float* gfin = INP(27);
    for (int t = gw; t < T; t += NGW) {
        f32x4* xr = (f32x4*)(outp + (size_t)t * D) + F.lane; const f32x4* gr = (const f32x4*)gfin + F.lane;
        f32x4 v[8]; float s = 0.f;
#pragma unroll
        for (int j = 0; j < 8; ++j) { v[j] = xr[64 * j]; s += (v[j].x * v[j].x + v[j].y * v[j].y) + (v[j].z * v[j].z + v[j].w * v[j].w); }
        const float rstd = 1.f / sqrtf(wave_sum(s) * (1.f / D) + EPS);
#pragma unroll
        for (int j = 0; j < 8; ++j) { const f32x4 g = gr[64 * j]; xr[64 * j] = v[j] * rstd * g; }
    }
}

constexpr int N_PHASES = 13;
__global__ void __launch_bounds__(NTHREADS, 2) mk_fwd(Args args) {
    extern __shared__ __attribute__((aligned(16))) unsigned char lds_raw[];
    Frame F;
    F.lds = (LAS unsigned char*)lds_raw; F.MISC = (volatile LAS unsigned*)(F.lds + MISC_OFF);
    F.wave = __builtin_amdgcn_readfirstlane((int)threadIdx.x >> 6); F.lane = (int)__builtin_amdgcn_mbcnt_hi(~0u, __builtin_amdgcn_mbcnt_lo(~0u, 0u)); F.tid = F.wave * 64 + F.lane;
    F.G = gridDim.x; { const int bx = blockIdx.x; F.vcu = (F.G % 8 == 0) ? (bx % 8) * (F.G / 8) + bx / 8 : bx; }
    for (int u = F.tid; u < (LDS_BYTES - LDSCTL_OFF) / 4; u += NTHREADS) ((LAS unsigned*)(F.lds + LDSCTL_OFF))[u] = 0u;
    __syncthreads();
    if (F.tid == 0) {
        LAS unsigned long long* tb = (LAS unsigned long long*)(F.lds + TBL_OFF);
#pragma unroll
        for (int k = 0; k < 28; ++k) tb[k] = (unsigned long long)args.in[k];
        tb[28] = (unsigned long long)args.out; tb[29] = (unsigned long long)args.ws;
    }
    const int lo = args.ph_lo, hi = args.ph_hi;
    __syncthreads();
    XcdBarrier bar; bar.bar = (unsigned*)(WSP + WS_CTL) + CW_BAR; bar.x = 0; bar.st = nullptr;
    const bool one_launch = (hi - lo) > 1;
    if (one_launch) bar = xcd_barrier_post(bar.bar, F.MISC + 8);
#ifndef PHASE_MASK
#define PHASE_MASK 0xFFFFu
#endif
#define IN(k) ((((PHASE_MASK) >> (k)) & 1u) && lo <= (k) && (k) < hi)
#define SEAM(k) do { if (IN(k) && IN((k) + 1)) xcd_barrier(bar); } while (0)
    const int bx = (int)blockIdx.x;
    volatile LAS int* ts = (volatile LAS int*)(F.MISC + 16);

#ifndef REPEAT_MASK
#define REPEAT_MASK 0u
#endif
#define PH(k, ...) do { if (IN(k)) { { __VA_ARGS__ } if (((REPEAT_MASK) >> (k)) & 1u) { if (one_launch) xcd_barrier(bar); { __VA_ARGS__ } } } SEAM(k); } while (0)
#ifndef BAR_EXTRA
#define BAR_EXTRA 0
#endif
    PH(0, p0_prologue(F););
    if (one_launch) for (int _b = 0; _b < BAR_EXTRA; ++_b) xcd_barrier(bar);
    PH(2, unsigned char* ws = WSP; SchedP1 S{(const char*)(ws + WS_XN), (const char*)(ws + WS_WIN), (const char*)(ws + WS_WB), (const char*)(ws + WS_WPS), F.G, bx};
        EpiP1 E{EpiZ{(bf16*)(ws + WS_Z)}, EpiPlain{(bf16*)(ws + WS_W2), 1024}}; g8::gemm_phase<false>(F.lds, F.wave, S, E););
    PH(3, p2_fast(F););
    PH(5, unsigned char* ws = WSP; SchedU S{(const char*)(ws + WS_YD), (const char*)(ws + WS_WA), (const char*)(ws + WS_W2), F.G, bx}; EpiU E{(bf16*)(ws + WS_XN), (const bf16*)(ws + WS_Z)}; g8::gemm_phase<false>(F.lds, F.wave, S, E););
    PH(6, unsigned char* ws = WSP; SchedDense S{(const char*)(ws + WS_XN), (const char*)(ws + WS_WOUT), 4096, 4096, 32, 32, 8, F.G, bx}; EpiX1 E{INP(0), (bf16*)(ws + WS_YD)}; g8::gemm_phase<false>(F.lds, F.wave, S, E););
    PH(7, p5_fast(F););
    PH(8, moe_table(F, ts); unsigned char* ws = WSP;
        SchedMoe S; S.wsb = (const char*)ws; S.ts = ts; S.init(F.G, F.vcu, __builtin_amdgcn_readfirstlane(ts[16]));
        EpiMoe E{ws};
        g8::gemm_phase<true>(F.lds, F.wave, S, E););
    PH(10, p8_combine(F););
    PH(11, unsigned char* ws = WSP;
        SchedDense S{(const char*)(ws + WS_YD), (const char*)(ws + WS_WPG), 4096, 4096, 32, 32, 8, F.G, bx};
        EpiPle E{OUTP, (const bf16*)(ws + WS_YD), (const bf16*)(ws + WS_XN), (const float*)(ws + WS_MISC + MI_RSTDP)}; g8::gemm_phase<false>(F.lds, F.wave, S, E););
    PH(12, p10_final(F););
#undef PH
#undef IN
#undef SEAM
}

extern "C" void kernel_launch(void* const* d_in, const int* in_sizes, int n_in, void* d_out, int out_size, void* d_ws, size_t ws_size, hipStream_t stream) {
    static int grid = 0;
    if (grid == 0) {
        if (n_in != 28 || in_sizes[0] != T * D || out_size != T * D || ws_size < WS_END) { fprintf(stderr, "kernel_launch: unexpected shapes / workspace (n_in %d, ws %zu < %zu)\n", n_in, ws_size, (size_t)WS_END); grid = -1; return; }
        int dev = 0, cus = 0, per_cu = 0;
        if (hipGetDevice(&dev) != hipSuccess || hipDeviceGetAttribute(&cus, hipDeviceAttributeMultiprocessorCount, dev) != hipSuccess) { grid = -1; return; }
        if (hipFuncSetAttribute((const void*)mk_fwd, hipFuncAttributeMaxDynamicSharedMemorySize, LDS_BYTES) != hipSuccess) { fprintf(stderr, "kernel_launch: hipFuncSetAttribute failed\n"); grid = -1; return; }
        if (hipOccupancyMaxActiveBlocksPerMultiprocessor(&per_cu, (const void*)mk_fwd, NTHREADS, LDS_BYTES) != hipSuccess || per_cu < 1) { fprintf(stderr, "kernel_launch: occupancy query says %d blocks/CU\n", per_cu); (void)hipGetLastError(); grid = -1; return; }
        grid = cus;
    }
    if (grid < 0) return;
    (void)hipMemsetAsync((char*)d_ws + WS_CTL, 0, CTL_ZERO_BYTES, stream);
    Args a{};
    for (int i = 0; i < 28; ++i) a.in[i] = (const float*)d_in[i];
    a.out = (float*)d_out; a.ws = (unsigned char*)d_ws;
#if MK_N_LAUNCHES == 1
    a.ph_lo = 0; a.ph_hi = N_PHASES;
    hipLaunchKernelGGL(mk_fwd, dim3(grid), dim3(NTHREADS), LDS_BYTES, stream, a);
#else
    for (int p = 0; p < N_PHASES; ++p) { a.ph_lo = p; a.ph_hi = p + 1; hipLaunchKernelGGL(mk_fwd, dim3(grid), dim3(NTHREADS), LDS_BYTES, stream, a); }
#endif
}
```

```cpp
#include <hip/hip_runtime.h>
#include <cstdio>
#include <cstdint>

#ifndef MK_N_LAUNCHES
#define MK_N_LAUNCHES 1
#endif

#define LAS __attribute__((address_space(3)))
#define GAS __attribute__((address_space(1)))
typedef unsigned short bf16;
typedef short bf16x8 __attribute__((ext_vector_type(8)));
typedef float f32x4 __attribute__((ext_vector_type(4)));
typedef float f32x2 __attribute__((ext_vector_type(2)));
typedef unsigned u32x4 __attribute__((ext_vector_type(4)));
typedef unsigned u32x2 __attribute__((ext_vector_type(2)));

constexpr int D = 2048, BATCH = 4, SEQ = 2048, T = BATCH * SEQ;
constexpr int PLE = 256, LRU_W = 1024, HD = 64, POOL_W = 1024, PGD = 256;
constexpr int IN_COLS = 7168, NE = 16, DE = 512;
constexpr float EPS = 1e-6f;
constexpr int NWAVES = 8, NTHREADS = 512;

constexpr size_t MiB = 1u << 20;
constexpr size_t WS_CTL = 0, CTL_ZERO_BYTES = 1 * MiB;
constexpr size_t WS_WIN = 1 * MiB;
constexpr size_t WS_WA = 29 * MiB;
constexpr size_t WS_WB = 33 * MiB;
constexpr size_t WS_W2 = 37 * MiB;
constexpr size_t WS_WOUT = 41 * MiB;
constexpr size_t WS_WPG = 49 * MiB;
constexpr size_t WS_WPP = 57 * MiB;
constexpr size_t WS_WPS = 58 * MiB;
constexpr size_t WS_MISC = 59 * MiB;
constexpr size_t WS_WGU = 60 * MiB;
constexpr size_t WS_WD = 124 * MiB;
constexpr size_t WS_XN = 156 * MiB;
constexpr size_t WS_Z = 188 * MiB;
constexpr size_t WS_YS = 188 * MiB;
constexpr size_t WS_ACT = 252 * MiB;
constexpr size_t WS_E = 272 * MiB;
constexpr size_t WS_YD = 300 * MiB;
constexpr size_t WS_PB = 332 * MiB;
constexpr size_t WS_LISTS = 336 * MiB;
constexpr size_t WS_END = 337 * MiB;
constexpr size_t MI_WRT = 524288  ;
constexpr size_t MI_RSTD2 = 0, MI_RSTDP = 32768, MI_CST = 65536  , MI_WRG = 131072  ;
constexpr size_t WS_LIST = WS_LISTS, WS_WL = WS_LISTS + 524288;
constexpr int CW_BAR = 4096;
constexpr int CW_CNT = 64;
constexpr size_t CTL_GRAN = 262144;

constexpr int RING_BYTES = 131072;
constexpr int LDSCTL_OFF = RING_BYTES, MISC_OFF = LDSCTL_OFF + 320;
constexpr int TBL_OFF = MISC_OFF + 256;
constexpr int LDS_BYTES = 147456;

#define RLX_AGENT __ATOMIC_RELAXED, __HIP_MEMORY_SCOPE_AGENT
#define LDS_WAIT() asm volatile("s_waitcnt lgkmcnt(0)" ::: "memory")
__device__ __forceinline__ unsigned f2bf(float f) { unsigned u = __builtin_bit_cast(unsigned, f); return (u + 0x7fffu + ((u >> 16) & 1u)) >> 16; }
__device__ __forceinline__ unsigned pk2(float lo, float hi) { return f2bf(lo) | (f2bf(hi) << 16); }
__device__ __forceinline__ float bf2f(unsigned b) { return __builtin_bit_cast(float, b << 16); }
__device__ __forceinline__ float bflo(unsigned w) { return __builtin_bit_cast(float, w << 16); }
__device__ __forceinline__ float bfhi(unsigned w) { return __builtin_bit_cast(float, w & 0xffff0000u); }
__device__ __forceinline__ float wave_sum(float v) {
#pragma unroll
    for (int o = 1; o < 64; o <<= 1) v += __shfl_xor(v, o);
    return v;
}
__device__ __forceinline__ float fsigmoid(float v) { return __builtin_amdgcn_rcpf(1.f + __expf(-v)); }
__device__ __forceinline__ float gelu_tanh(float v) { const float u = 1.5957691216057308f * (v + 0.044715f * v * v * v); return v * fsigmoid(u); }

__device__ __forceinline__ const void* ld_ptr(LAS unsigned char* lds, int k) {
    const volatile LAS unsigned* p = (const volatile LAS unsigned*)(lds + TBL_OFF) + 2 * k;
    const unsigned lo = __builtin_amdgcn_readfirstlane(p[0]), hi = __builtin_amdgcn_readfirstlane(p[1]);
    return (const void*)(((unsigned long long)hi << 32) | lo);
}
#define INP(k) ((const float*)ld_ptr(F.lds, (k)))
#define OUTP ((float*)ld_ptr(F.lds, 28))
#define WSP ((unsigned char*)ld_ptr(F.lds, 29))

namespace g8 {
constexpr int BM = 256, BK = 64, HALF = 128, HTB = HALF * BK * 2, NXCD = 8, WGM = 8;
__host__ __device__ __forceinline__ int lds_byte(int r, int c) { const int st = (r >> 4) * 2 + (c >> 5), rr = r & 15, cc = c & 31, ob = rr * 64 + cc * 2; return st * 1024 + (ob ^ (((ob >> 9) & 1) << 5)); }
__host__ __device__ __forceinline__ void stage_rc(int b, int& R, int& C) { const int st = b / 1024, sb = b % 1024, swz = sb ^ (((sb >> 9) & 1) << 5); R = (st >> 1) * 16 + swz / 64; C = (st & 1) * 32 + (swz % 64) / 2; }
__host__ __device__ __forceinline__ int perm32(int rho) { const int n = rho >> 4, i = rho & 15; return 8 * (i >> 2) + 4 * n + (i & 3); }

struct GU {
    const char* A; const char* B;
    const int* gl; int gn;
    unsigned lda;
    int nt;
    int pm, pn, aux;
};
__device__ __forceinline__ void tile_of(int L, int nM, int nN, int& pm, int& pn) {
    const int nwg = nM * nN; int wgid = L; { const int q = nwg / NXCD, r = nwg % NXCD, xcd = wgid % NXCD, off = wgid / NXCD; wgid = (xcd < r ? xcd * (q + 1) : r * (q + 1) + (xcd - r) * q) + off; }
    const int nig = WGM * nN, gid = wgid / nig, fm = gid * WGM, gsz = (nM - fm) < WGM ? (nM - fm) : WGM;
    pm = fm + ((wgid % nig) % gsz); pn = (wgid % nig) / gsz;
}
__device__ __forceinline__ unsigned cvt_pk_bf16(float lo, float hi) { unsigned r; asm volatile("v_cvt_pk_bf16_f32 %0, %1, %2" : "=v"(r) : "v"(lo), "v"(hi)); return r; }

__device__ __forceinline__ const char* uni_ptr(const char* p) { const unsigned long long v = (unsigned long long)p; const unsigned lo = __builtin_amdgcn_readfirstlane((unsigned)v), hi = __builtin_amdgcn_readfirstlane((unsigned)(v >> 32)); return (const char*)(((unsigned long long)hi << 32) | lo); }
__device__ __forceinline__ void uni_unit(GU& u) { u.A = uni_ptr(u.A); u.B = uni_ptr(u.B); u.lda = __builtin_amdgcn_readfirstlane(u.lda); u.nt = __builtin_amdgcn_readfirstlane(u.nt); }
template <int OFF> __device__ __forceinline__ void glds16(const char* sbase, unsigned voff, unsigned lds_base) {
    unsigned keep;
    asm volatile("s_mov_b32 %0, m0\n\ts_add_u32 m0, %3, %4\n\ts_nop 2\n\tglobal_load_lds_dwordx4 %1, %2\n\ts_mov_b32 m0, %0" : "=&s"(keep) : "v"(voff), "s"(sbase), "s"(lds_base), "i"(OFF) : "memory", "scc");
}
template <bool GATHER, class Epi, class Sched>
__device__ __forceinline__ void gemm_phase(LAS unsigned char* lds, int wave, const Sched& S, const Epi& E) {
    const int wid = wave, lane = (int)__builtin_amdgcn_mbcnt_hi(~0u, __builtin_amdgcn_mbcnt_lo(~0u, 0u)), tid = wid * 64 + lane;
    const int wr = wid >> 2, wc = wid & 3, fr = lane & 15, fq = lane >> 4;
    const unsigned ldsbw = (unsigned)(uintptr_t)lds + (unsigned)wid * 1024u;
    const int aoff = lds_byte(wr * 64 + fr, fq * 8), boff = lds_byte(wc * 32 + fr, fq * 8);
#define G8_OFFS(u, vA, vB) do { int _t = tid; asm volatile("" : "+v"(_t)); int sR[2], sRp[2], sC[2];     \
        _Pragma("unroll") for (int _i = 0; _i < 2; ++_i) { stage_rc(_t * 16 + _i * 8192, sR[_i], sC[_i]); sRp[_i] = (sR[_i] & ~31) + perm32(sR[_i] & 31); } \
        _Pragma("unroll") for (int _h = 0; _h < (GATHER ? 2 : 1); ++_h) _Pragma("unroll") for (int _i = 0; _i < 2; ++_i) { const int _r = _h * HALF + sR[_i]; int _row = _r; \
            if (GATHER && (u).gl) { _row = 0; if (_r < (u).gn) _row = (u).gl[_r] >> 1; } vA[_h][_i] = (unsigned)_row * (u).lda + (unsigned)sC[_i] * 2u; } \
        _Pragma("unroll") for (int _i = 0; _i < 2; ++_i) vB[_i] = (unsigned)sRp[_i] * ((unsigned)(u).nt * 128u) + (unsigned)sC[_i] * 2u; } while (0)
#define G8_SA(b, h) (((b) * 2 + (h)) * HTB)
#define G8_SB(b, h) ((4 + (b) * 2 + (h)) * HTB)
#define G8_STAGE(bufoff, gbase, voff) do { const char* _gb = uni_ptr((const char*)(gbase)); glds16<(bufoff)>(_gb, (voff)[0], ldsbw); glds16<(bufoff) + 8192>(_gb, (voff)[1], ldsbw); } while (0)
#define G8_LDA(dst, b, h) do { _Pragma("unroll") for (int m = 0; m < 4; ++m) _Pragma("unroll") for (int k = 0; k < 2; ++k) dst[m][k] = *(const LAS bf16x8*)(lds + G8_SA(b, h) + aoff + m * 2048 + k * 1024); } while (0)
#define G8_LDB(dst, b, h) do { _Pragma("unroll") for (int n = 0; n < 2; ++n) _Pragma("unroll") for (int k = 0; k < 2; ++k) dst[n][k] = *(const LAS bf16x8*)(lds + G8_SB(b, h) + boff + n * 2048 + k * 1024); } while (0)
#define G8_MMA(ai, bj, At, Bt) do { __builtin_amdgcn_s_setprio(1); _Pragma("unroll") for (int m = 0; m < 4; ++m) _Pragma("unroll") for (int n = 0; n < 2; ++n) _Pragma("unroll") for (int k = 0; k < 2; ++k) \
        acc[ai][bj][m][n] = __builtin_amdgcn_mfma_f32_16x16x32_bf16(Bt[n][k], At[m][k], acc[ai][bj][m][n], 0, 0, 0); __builtin_amdgcn_s_setprio(0); } while (0)
#define G8_WAIT_V(n) asm volatile("s_waitcnt vmcnt(" #n ")" ::: "memory")
#define G8_WAIT_L(n) asm volatile("s_waitcnt lgkmcnt(" #n ")" ::: "memory")
#define G8_BAR __builtin_amdgcn_s_barrier()
#define G8_SCHED __builtin_amdgcn_sched_barrier(0)
    GU cur, nxt; int ui = 0;
    if (!S.next(0, cur)) return;
    uni_unit(cur);
    f32x4 acc[2][2][4][2];
#pragma unroll
    for (int a = 0; a < 2; ++a)
#pragma unroll
        for (int b = 0; b < 2; ++b)
#pragma unroll
            for (int m = 0; m < 4; ++m)
#pragma unroll
                for (int n = 0; n < 2; ++n) acc[a][b][m][n] = (f32x4){0.f, 0.f, 0.f, 0.f};
    bf16x8 At[4][2], B0[2][2], B1[2][2];
    unsigned vA[2][2], vB[2];
    S.a_ready(cur, wid);
    G8_OFFS(cur, vA, vB);
    const char* cA = cur.A; const char* cB = cur.B; unsigned chB = HALF * (unsigned)cur.nt * 128u, chA = GATHER ? 0u : HALF * cur.lda;
    {
        G8_STAGE(G8_SB(0, 0), cB, vB); G8_STAGE(G8_SB(0, 1), cB + chB, vB); G8_STAGE(G8_SA(0, 0), cA, vA[0]); G8_STAGE(G8_SA(0, 1), cA + chA, vA[GATHER ? 1 : 0]);
        if (wr == 1) G8_BAR;
        G8_WAIT_V(2); G8_BAR;
        G8_STAGE(G8_SB(1, 0), cB + 128, vB); G8_STAGE(G8_SA(1, 0), cA + 128, vA[0]); G8_STAGE(G8_SB(1, 1), cB + chB + 128, vB);
        G8_WAIT_V(6); G8_BAR;
    }
    for (;;) {
        const bool has_next = S.next(ui + 1, nxt); if (has_next) uni_unit(nxt);
        int nt = __builtin_amdgcn_readfirstlane(cur.nt); asm volatile("" : "+s"(nt));
        for (int t = 0; t < nt; t += 2) {
            const bool last = (t == nt - 2);
            const char* a1 = cA + (size_t)(t + 1) * 128;
            G8_LDB(B0, 0, 0); G8_LDB(B1, 0, 1); G8_SCHED; G8_LDA(At, 0, 0); G8_STAGE(G8_SA(1, 1), a1 + chA, vA[GATHER ? 1 : 0]);
            const char* a2; const char* b2; unsigned xhB, xhA;
            if (last) {
                if (has_next) { S.a_ready(nxt, wid); G8_OFFS(nxt, vA, vB); a2 = nxt.A; b2 = nxt.B; xhB = HALF * (unsigned)nxt.nt * 128u; xhA = GATHER ? 0u : HALF * nxt.lda; }
                else { a2 = cA; b2 = cB; xhB = chB; xhA = chA; }
            } else { a2 = cA + (size_t)(t + 2) * 128; b2 = cB + (size_t)(t + 2) * 128; xhB = chB; xhA = chA; }
            const char* a3 = a2 + 128; const char* b3 = b2 + 128;
            G8_WAIT_V(8); G8_WAIT_L(0); G8_BAR; G8_MMA(0, 0, At, B0); G8_MMA(0, 1, At, B1); G8_BAR; G8_SCHED;
            G8_LDA(At, 0, 1); G8_STAGE(G8_SB(0, 0), b2, vB); G8_STAGE(G8_SB(0, 1), b2 + xhB, vB); G8_STAGE(G8_SA(0, 0), a2, vA[0]);
            G8_WAIT_V(8); G8_WAIT_L(0); G8_BAR; G8_MMA(1, 0, At, B0); G8_MMA(1, 1, At, B1); G8_BAR; G8_SCHED;
            G8_LDB(B0, 1, 0); G8_LDB(B1, 1, 1); G8_SCHED; G8_LDA(At, 1, 0); G8_STAGE(G8_SA(0, 1), a2 + xhA, vA[GATHER ? 1 : 0]);
            G8_WAIT_V(8); G8_WAIT_L(0); G8_BAR; G8_MMA(0, 0, At, B0); G8_MMA(0, 1, At, B1); G8_BAR; G8_SCHED;
            G8_LDA(At, 1, 1); G8_STAGE(G8_SB(1, 0), b3, vB); G8_STAGE(G8_SB(1, 1), b3 + xhB, vB); G8_STAGE(G8_SA(1, 0), a3, vA[0]);
            G8_WAIT_V(8); G8_WAIT_L(0); G8_BAR; G8_MMA(1, 0, At, B0); G8_MMA(1, 1, At, B1); G8_BAR; G8_SCHED;
        }
        if (wr == 0) G8_BAR;
        if constexpr (!Epi::AFTER_DRAIN) { E(acc, cur, wr, wc, fr, fq); S.done(cur, lane); }
        if (!has_next) break;
#pragma unroll
        for (int a = 0; a < 2; ++a)
#pragma unroll
            for (int b = 0; b < 2; ++b)
#pragma unroll
                for (int m = 0; m < 4; ++m)
#pragma unroll
                    for (int n = 0; n < 2; ++n) acc[a][b][m][n] = (f32x4){0.f, 0.f, 0.f, 0.f};
        cur = nxt; cA = cur.A; cB = cur.B; chB = HALF * (unsigned)cur.nt * 128u; chA = GATHER ? 0u : HALF * cur.lda; ++ui;
        if (wr == 1) G8_BAR;
    }
    G8_WAIT_V(0);
    G8_BAR;
    if constexpr (Epi::AFTER_DRAIN) E.fused(acc, cur, wr, wc, fr, fq, lds, wid, lane);
#undef G8_OFFS
#undef G8_SA
#undef G8_SB
#undef G8_STAGE
#undef G8_LDA
#undef G8_LDB
#undef G8_MMA
#undef G8_WAIT_V
#undef G8_WAIT_L
#undef G8_BAR
#undef G8_SCHED
}
}
using g8::GU;

#define XB_TMO      128
#define XB_XCNT(j)  (256  + 64 * (j))
#define XB_XSUB(j)  (1280 + 64 * (j))
#define XB_XGEN(j)  (2304 + 64 * (j))
#define XB_TOP      3328
#define XB_TOPGEN   3392
#define XCD_BAR_WORDS 3456
#define XB_SPIN_CAP (1u << 18)
__device__ __forceinline__ unsigned xb_ld(unsigned* p)              { return __hip_atomic_load(p, __ATOMIC_RELAXED, __HIP_MEMORY_SCOPE_AGENT); }
__device__ __forceinline__ unsigned xb_add(unsigned* p, unsigned v) { return __hip_atomic_fetch_add(p, v, __ATOMIC_RELAXED, __HIP_MEMORY_SCOPE_AGENT); }
__device__ __forceinline__ unsigned xb_xcc_id() { return (unsigned)__builtin_amdgcn_s_getreg((3 << 11) | 20) & 0xFu; }
#define XB_SPIN(cond, bar) do { unsigned _sp = 0; while (cond) { __builtin_amdgcn_s_sleep(1); \
    if ((++_sp & 255u) == 0u) { if (xb_ld(&(bar)[XB_TMO])) break; if (_sp > XB_SPIN_CAP) { atomicAdd(&(bar)[XB_TMO], 1u); break; } } } } while (0)
struct XcdBarrier { unsigned* bar; unsigned x; volatile LAS unsigned* st; };
__device__ __forceinline__ XcdBarrier xcd_barrier_post(unsigned* bar, volatile LAS unsigned* st) {
    XcdBarrier b; b.bar = bar; b.x = xb_xcc_id(); b.st = st;
    if (threadIdx.x == 0) (void)xb_add(&bar[XB_XCNT(b.x)], 1u);
    return b;
}
__device__ __forceinline__ void xcd_barrier_complete(unsigned* bar, unsigned x, unsigned& nloc, unsigned& nx) {
    const unsigned G = gridDim.x * gridDim.y * gridDim.z;
    unsigned sum, cnt, mine, sp = 0u;
    for (;;) {
        sum = 0u; cnt = 0u; mine = 0u;
#pragma unroll
        for (unsigned j = 0; j < 16; ++j) { const unsigned c = xb_ld(&bar[XB_XCNT(j)]); sum += c; cnt += (c > 0u) ? 1u : 0u; mine = (j == x) ? c : mine; }
        if (sum == G) break;
        __builtin_amdgcn_s_sleep(1);
        if ((++sp & 255u) == 0u) { if (xb_ld(&bar[XB_TMO])) break; if (sp > XB_SPIN_CAP) { atomicAdd(&bar[XB_TMO], 1u); break; } }
    }
    nloc = mine > 0u ? mine : 1u; nx = cnt > 0u ? cnt : 1u;
}
__device__ __forceinline__ void xcd_barrier(const XcdBarrier& b) {
    asm volatile("s_waitcnt vmcnt(0)" ::: "memory");
    __syncthreads();
    if (threadIdx.x == 0) {
        unsigned* bar = b.bar;
        __builtin_amdgcn_s_waitcnt(0);
        unsigned nloc = b.st[0], nx = b.st[1];
        if (nloc == 0u) { xcd_barrier_complete(bar, b.x, nloc, nx); b.st[0] = nloc; b.st[1] = nx; }
        const unsigned old = xb_add(&bar[XB_XSUB(b.x)], 1u);
        const unsigned gen = old / nloc;
        if (old + 1u == (gen + 1u) * nloc) {
            __builtin_amdgcn_fence(__ATOMIC_RELEASE, "agent");
            asm volatile("s_waitcnt vmcnt(0)" ::: "memory");
            const unsigned og = xb_add(&bar[XB_TOP], 1u);
            const unsigned tg = og / nx;
            if (og + 1u == (tg + 1u) * nx) xb_add(&bar[XB_TOPGEN], 1u);
            else XB_SPIN(xb_ld(&bar[XB_TOPGEN]) == tg, bar);
            __builtin_amdgcn_fence(__ATOMIC_ACQUIRE, "agent");
            xb_add(&bar[XB_XGEN(b.x)], 1u);
            asm volatile("s_waitcnt vmcnt(0)" ::: "memory");
        } else {
            XB_SPIN(xb_ld(&bar[XB_XGEN(b.x)]) == gen, bar);
            __builtin_amdgcn_fence(__ATOMIC_ACQUIRE, "agent");
            asm volatile("s_waitcnt vmcnt(0)" ::: "memory");
        }
    }
    __syncthreads();
}

struct Args { const float* in[28]; float* out; unsigned char* ws; int ph_lo, ph_hi; };
struct Frame {
    LAS unsigned char* lds; volatile LAS unsigned* MISC;
    int tid, lane, wave, vcu, G;
};

struct TItem { const float* src; bf16* dst; const float* ks; int ldw, ldt; };
__device__ __forceinline__ bool p0_decode(Frame& F, unsigned char* ws, int it, TItem& t) {
    constexpr int I_IN = (D / 64) * (IN_COLS / 32), I_A = (LRU_W / 64) * (D / 32), I_O = (D / 64) * (D / 32), I_PP = (PLE / 64) * (D / 32);
    constexpr int I_EG = (D / 64) * (DE / 32), I_ED = (DE / 64) * (D / 32);
    constexpr int NITEMS = I_IN + 2 * I_A + 2 * I_O + I_PP + 2 * NE * I_EG + NE * I_ED;
    if (it >= NITEMS) return false;
    int r = it; const float* W; bf16* WT; int ldw, ldt, kb, n0, drow0; const float* ks = nullptr;
    if (r < I_IN) { const int nb = IN_COLS / 32; W = INP(3); ldw = IN_COLS; kb = r / nb; n0 = 32 * (r % nb); WT = (bf16*)(ws + WS_WIN); ldt = D; drow0 = n0; }
    else if ((r -= I_IN) < I_A) { const int nb = D / 32; W = INP(13); ldw = D; kb = r / nb; n0 = 32 * (r % nb); WT = (bf16*)(ws + WS_WA); ldt = LRU_W; drow0 = n0; }
    else if ((r -= I_A) < I_A) { const int nb = D / 32; W = INP(14); ldw = D; kb = r / nb; n0 = 32 * (r % nb); WT = (bf16*)(ws + WS_WB); ldt = POOL_W; drow0 = n0; }
    else if ((r -= I_A) < I_O) { const int nb = D / 32; W = INP(15); ldw = D; kb = r / nb; n0 = 32 * (r % nb); WT = (bf16*)(ws + WS_WOUT); ldt = D; drow0 = n0; }
    else if ((r -= I_O) < I_O) { const int nb = D / 32; W = INP(25); ldw = D; kb = r / nb; n0 = 32 * (r % nb); WT = (bf16*)(ws + WS_WPG); ldt = D; drow0 = n0; ks = INP(24); }
    else if ((r -= I_O) < I_PP) { const int nb = D / 32; W = INP(26); ldw = D; kb = r / nb; n0 = 32 * (r % nb); WT = (bf16*)(ws + WS_WPP); ldt = PLE; drow0 = n0; }
    else if ((r -= I_PP) < 2 * NE * I_EG) {
        const int up = r / (NE * I_EG); r -= up * NE * I_EG; const int e = r / I_EG; r -= e * I_EG; const int nb = DE / 32; kb = r / nb; n0 = 32 * (r % nb);
        W = (up ? INP(22) : INP(21)) + (size_t)e * D * DE; ldw = DE; WT = (bf16*)(ws + WS_WGU); ldt = D; drow0 = e * 1024 + (n0 / 128) * 256 + up * 128 + (n0 % 128); ks = INP(16); }
    else { r -= 2 * NE * I_EG; const int e = r / I_ED; r -= e * I_ED; const int nb = D / 32; kb = r / nb; n0 = 32 * (r % nb);
        W = INP(23) + (size_t)e * DE * D; ldw = D; WT = (bf16*)(ws + WS_WD); ldt = DE; drow0 = e * D + n0; }
    t.src = W + (size_t)(64 * kb) * ldw + n0; t.dst = WT + (size_t)drow0 * ldt + 64 * kb; t.ks = ks ? ks + 64 * kb : nullptr; t.ldw = ldw; t.ldt = ldt; return true;
}
__device__ __forceinline__ void p0_load(const TItem& t, float (&v)[32], int lane) {
    const float* p = t.src + (size_t)(lane >> 5) * t.ldw + (lane & 31);
#pragma unroll
    for (int i = 0; i < 32; ++i) v[i] = p[(size_t)(2 * i) * t.ldw];
}
__device__ __forceinline__ void p0_store(const TItem& t, const float (&v)[32], LAS float* scr, int lane) {
    if (t.ks) {
#pragma unroll
        for (int i = 0; i < 32; ++i) scr[(2 * i + (lane >> 5)) * 33 + (lane & 31)] = v[i] * t.ks[2 * i + (lane >> 5)];
    } else {
#pragma unroll
        for (int i = 0; i < 32; ++i) scr[(2 * i + (lane >> 5)) * 33 + (lane & 31)] = v[i];
    }
    LDS_WAIT(); asm volatile("" ::: "memory");
    const int c = lane & 7;
#pragma unroll
    for (int j = 0; j < 4; ++j) { const int n = (lane >> 3) + 8 * j; const LAS float* s = scr + (8 * c) * 33 + n;
        u32x4 o; o.x = pk2(s[0 * 33], s[1 * 33]); o.y = pk2(s[2 * 33], s[3 * 33]); o.z = pk2(s[4 * 33], s[5 * 33]); o.w = pk2(s[6 * 33], s[7 * 33]);
        *(u32x4*)(t.dst + (size_t)n * t.ldt + 8 * c) = o; }
    LDS_WAIT(); asm volatile("" ::: "memory");
}
__device__ __forceinline__ void p0_prologue(Frame& F) {
    LAS float* scr = (LAS float*)(F.lds + F.wave * 16384);
    const int gw = F.vcu * NWAVES + F.wave, NGW = F.G * NWAVES;
    unsigned char* ws = WSP;
    {
        TItem ta, tb; float va[32], vb[32]; int it = gw;
        bool ha = p0_decode(F, ws, it, ta); if (ha) p0_load(ta, va, F.lane);
        while (ha) {
            const bool hb = p0_decode(F, ws, it + NGW, tb); if (hb) p0_load(tb, vb, F.lane);
            p0_store(ta, va, scr, F.lane);
            if (!hb) break;
            it += 2 * NGW; ha = p0_decode(F, ws, it, ta); if (ha) p0_load(ta, va, F.lane);
            p0_store(tb, vb, scr, F.lane);
        }
    }
    const size_t gt = (size_t)(F.vcu * NTHREADS + F.tid), NGT = (size_t)F.G * NTHREADS;
    for (size_t i = gt; i < (size_t)4 * PGD * PGD / 4; i += NGT) { const f32x4 v = ((const f32x4*)INP(11))[i]; const int g = (int)(i / (PGD * PGD / 4)), d0 = (int)((i * 4) % PGD); const float* sc = INP(12) + g * PGD + d0;
        u32x2 o; o.x = pk2(v.x * sc[0], v.y * sc[1]); o.y = pk2(v.z * sc[2], v.w * sc[3]); ((u32x2*)(ws + WS_WPS))[i] = o; }
    for (size_t i = gt; i < (size_t)T * PLE / 4; i += NGT) { const f32x4 v = ((const f32x4*)INP(1))[i]; u32x2 o; o.x = pk2(v.x, v.y); o.y = pk2(v.z, v.w); ((u32x2*)(ws + WS_PB))[i] = o; }
    for (size_t i = gt; i < (size_t)16 * 8 * 64; i += NGT) { const int h = (int)(i >> 9), row = (int)(i >> 6) & 7, j = (int)i & 63, c = h * 64 + j; float v;
        if (row < 4) v = INP(4)[row * LRU_W + c]; else if (row == 4) v = INP(5)[c]; else if (row == 5) v = INP(7)[c]; else if (row == 6) v = INP(9)[c]; else v = 8.0f * log1pf(expf(-INP(10)[c]));
        ((float*)(ws + WS_MISC + MI_CST))[i] = v; }
    for (size_t i = gt; i < (size_t)16 * 24 * 64; i += NGT) { const int h = (int)(i / (24 * 64)), fi = (int)(i / 64) % 24, ln = (int)i & 63, nt = fi >> 1, sx = fi & 1, fr_ = ln & 15, fq_ = ln >> 4;
        float v[8];
#pragma unroll
        for (int j = 0; j < 8; ++j) { const int k = 32 * sx + 8 * fq_ + j;
            if (nt < 4) v[j] = INP(6)[(h * 64 + k) * 64 + 16 * nt + fr_]; else if (nt < 8) v[j] = INP(8)[(h * 64 + k) * 64 + 16 * (nt - 4) + fr_]; else v[j] = (k == 16 * (nt - 8) + fr_) ? 1.0f : 0.0f; }
        u32x4 o; o.x = pk2(v[0], v[1]); o.y = pk2(v[2], v[3]); o.z = pk2(v[4], v[5]); o.w = pk2(v[6], v[7]); ((u32x4*)(ws + WS_MISC + MI_WRG))[i] = o; }
    for (size_t i = gt; i < (size_t)64 * 2 * 64; i += NGT) { const int ks = (int)(i >> 7), nt = (int)(i >> 6) & 1, ln = (int)i & 63, fr_ = ln & 15, fq_ = ln >> 4, n = 16 * nt + fr_;
        float hi[8], lo[8];
#pragma unroll
        for (int j = 0; j < 8; ++j) { const int k = 32 * ks + 8 * fq_ + j; float v = 0.f; if (n < 4) v = INP(17)[k * 4 + n]; else if (n < 20) v = INP(19)[k * 16 + (n - 4)];
            v *= INP(16)[k]; hi[j] = bf2f(f2bf(v)); lo[j] = v - hi[j]; }
        u32x4 oh, ol; oh.x = pk2(hi[0], hi[1]); oh.y = pk2(hi[2], hi[3]); oh.z = pk2(hi[4], hi[5]); oh.w = pk2(hi[6], hi[7]); ol.x = pk2(lo[0], lo[1]); ol.y = pk2(lo[2], lo[3]); ol.z = pk2(lo[4], lo[5]); ol.w = pk2(lo[6], lo[7]);
        u32x4* dst = (u32x4*)(ws + WS_MISC + MI_WRT) + ((size_t)(ks * 2 + nt) * 2) * 64 + ln; dst[0] = oh; dst[64] = ol; }
    for (int m = gw; m < T; m += NGW) {
        const f32x4* xr = (const f32x4*)(INP(0) + (size_t)m * D) + F.lane; const f32x4* gr = (const f32x4*)INP(2) + F.lane;
        f32x4 v[8]; float s = 0.f;
#pragma unroll
        for (int j = 0; j < 8; ++j) { v[j] = xr[64 * j]; s += (v[j].x * v[j].x + v[j].y * v[j].y) + (v[j].z * v[j].z + v[j].w * v[j].w); }
        const float rstd = 1.f / sqrtf(wave_sum(s) * (1.f / D) + EPS);
        u32x2* o8 = (u32x2*)(ws + WS_XN + (size_t)m * D * 2) + F.lane;
#pragma unroll
        for (int j = 0; j < 8; ++j) { const f32x4 g = gr[64 * j]; u32x2 o; o.x = pk2(v[j].x * rstd * g.x, v[j].y * rstd * g.y); o.y = pk2(v[j].z * rstd * g.z, v[j].w * rstd * g.w); o8[64 * j] = o; }
    }
}

struct SchedDense { __device__ __forceinline__ void a_ready(const GU&, int) const {} __device__ __forceinline__ void done(const GU&, int) const {}
    const char* A; const char* B; unsigned lda, ldb; int nt, nM, nN, G, c;
    __device__ __forceinline__ bool next(int i, GU& u) const {
        const int L = i * G + c; if (L >= nM * nN) return false;
        g8::tile_of(L, nM, nN, u.pm, u.pn);
        u.A = A + (size_t)u.pm * 256 * lda; u.B = B + (size_t)u.pn * 256 * ldb; u.gl = nullptr; u.gn = 0; u.lda = lda; u.nt = nt; u.aux = 0; return true;
    }
};
struct SchedP1 { __device__ __forceinline__ void a_ready(const GU&, int) const {} __device__ __forceinline__ void done(const GU&, int) const {}
    const char* XN; const char* WIN; const char* WBt; const char* WPS; int G, c;
    __device__ __forceinline__ bool next(int i, GU& u) const {
        const int L = __builtin_amdgcn_readfirstlane(i * G + c); if (L >= 896 + 32) return false;
        u.gl = nullptr; u.gn = 0;
        if (L < 896) { g8::tile_of(L, 32, 28, u.pm, u.pn); u.A = XN + (size_t)u.pm * 256 * 4096; u.B = WIN + (size_t)u.pn * 256 * 4096; u.lda = 4096; u.nt = 32; u.aux = 0; return true; }
        const int J = L - 896, g = J >> 3; u.pm = J & 7; u.pn = 0; u.aux = 256 * g;
        u.A = WBt + (size_t)u.pm * 256 * 2048 + (size_t)g * 512; u.B = WPS + (size_t)g * PGD * PGD * 2; u.lda = 2048; u.nt = 4; return true;
    }
};
struct SchedW2 { __device__ __forceinline__ void a_ready(const GU&, int) const {} __device__ __forceinline__ void done(const GU&, int) const {}
    const char* WBt; const char* WPS; int G, c;
    __device__ __forceinline__ bool next(int i, GU& u) const {
        const int L = i * G + c; if (L >= 32) return false;
        const int g = L >> 3; u.pm = L & 7; u.pn = 0; u.aux = 256 * g;
        u.A = WBt + (size_t)u.pm * 256 * 2048 + (size_t)g * 512; u.B = WPS + (size_t)g * PGD * PGD * 2; u.gl = nullptr; u.gn = 0; u.lda = 2048; u.nt = 4; return true;
    }
};
struct SchedU { __device__ __forceinline__ void a_ready(const GU&, int) const {} __device__ __forceinline__ void done(const GU&, int) const {}
    const char* YD; const char* WA; const char* W2; int G, c;
    __device__ __forceinline__ bool next(int i, GU& u) const {
        const int L = (i >> 1) * G + c; if (L >= 256) return false;
        const int src = i & 1; g8::tile_of(L, 32, 8, u.pm, u.pn);
        u.A = YD + (size_t)u.pm * 256 * 4096 + src * 2048; u.B = (src ? W2 : WA) + (size_t)u.pn * 256 * 2048; u.gl = nullptr; u.gn = 0; u.lda = 4096; u.nt = 16; u.aux = src; return true;
    }
};
struct SchedMoeUp { __device__ __forceinline__ void a_ready(const GU&, int) const {} __device__ __forceinline__ void done(const GU&, int) const {}
    const char* X; const char* W; const int* list; const int* cnt; const volatile LAS int* ts; int G, c;
    __device__ __forceinline__ bool next(int i, GU& u) const {
        const int L = i * G + c; const int ntile = __builtin_amdgcn_readfirstlane(ts[16]); if (L >= 4 * ntile) return false;
        const int rt = L >> 2, pn = L & 3; int e = 0;
#pragma unroll
        for (int j = 1; j < 16; ++j) e += (rt >= ts[j]) ? 1 : 0;
        e = __builtin_amdgcn_readfirstlane(e);
        const int i0 = __builtin_amdgcn_readfirstlane(rt - ts[e]); int gn = __builtin_amdgcn_readfirstlane(cnt[e]) - 256 * i0; gn = gn > 256 ? 256 : gn;
        u.A = X; u.gl = list + e * T + 256 * i0; u.gn = gn; u.lda = 4096; u.B = W + ((size_t)e * 1024 + 256 * pn) * 4096; u.nt = 32; u.pm = rt; u.pn = pn; u.aux = e; return true;
    }
};
struct SchedE { __device__ __forceinline__ void a_ready(const GU&, int) const {} __device__ __forceinline__ void done(const GU&, int) const {}
    const char* PB; const char* WPP; int first, nfree, rank;
    __device__ __forceinline__ bool next(int i, GU& u) const {
        if (rank < 0) return false; const int L = rank + i * nfree; if (L >= 256) return false;
        g8::tile_of(L, 32, 8, u.pm, u.pn); u.A = PB + (size_t)u.pm * 256 * 512; u.B = WPP + (size_t)u.pn * 256 * 512; u.gl = nullptr; u.gn = 0; u.lda = 512; u.nt = 4; u.aux = 0; return true;
    }
};
struct SchedMoeDown { __device__ __forceinline__ void a_ready(const GU&, int) const {} __device__ __forceinline__ void done(const GU&, int) const {}
    const char* ACT; const char* W; const int* list; const int* cnt; const volatile LAS int* ts; int G, c;
    __device__ __forceinline__ bool next(int i, GU& u) const {
        const int L = i * G + c; const int ntile = __builtin_amdgcn_readfirstlane(ts[16]); if (L >= 8 * ntile) return false;
        const int rt = L >> 3, pn = L & 7; int e = 0;
#pragma unroll
        for (int j = 1; j < 16; ++j) e += (rt >= ts[j]) ? 1 : 0;
        e = __builtin_amdgcn_readfirstlane(e);
        const int i0 = __builtin_amdgcn_readfirstlane(rt - ts[e]); int gn = __builtin_amdgcn_readfirstlane(cnt[e]) - 256 * i0; gn = gn > 256 ? 256 : gn;
        u.A = ACT + (size_t)rt * 256 * 1024; u.gl = nullptr; u.gn = gn; u.lda = 1024; u.B = W + ((size_t)e * 2048 + 256 * pn) * 1024; u.nt = 8; u.pm = rt; u.pn = pn; u.aux = e * T + 256 * i0; return true;
    }
};

#define EPI_ROWS_BEGIN  _Pragma("unroll") for (int ai = 0; ai < 2; ++ai) _Pragma("unroll") for (int m = 0; m < 4; ++m) { const int r = ai * 128 + wr * 64 + m * 16 + fr;
#define EPI_ROWS_END    asm volatile("" ::: "memory"); }
struct EpiPlain { static constexpr bool AFTER_DRAIN = false;
    bf16* O; int ldc;
    __device__ __forceinline__ void operator()(const f32x4 (&acc)[2][2][4][2], const GU& u, int wr, int wc, int fr, int fq) const {
        const int col0 = u.pn * 256 + u.aux + wc * 32 + 8 * fq;
        EPI_ROWS_BEGIN
            bf16* rowp = O + (size_t)(u.pm * 256 + r) * ldc + col0;
#pragma unroll
            for (int bj = 0; bj < 2; ++bj) { const f32x4 v0 = acc[ai][bj][m][0], v1 = acc[ai][bj][m][1];
                u32x4 w; w.x = g8::cvt_pk_bf16(v0[0], v0[1]); w.y = g8::cvt_pk_bf16(v0[2], v0[3]); w.z = g8::cvt_pk_bf16(v1[0], v1[1]); w.w = g8::cvt_pk_bf16(v1[2], v1[3]);
                *(u32x4*)(rowp + bj * 128) = w; }
        EPI_ROWS_END
    }
};
struct EpiZ { static constexpr bool AFTER_DRAIN = false;
    bf16* Z;
    __device__ __forceinline__ void operator()(const f32x4 (&acc)[2][2][4][2], const GU& u, int wr, int wc, int fr, int fq) const {
        const int col0 = u.pn * 256 + wc * 32 + 8 * fq; const int kind = (u.pn >= 12) ? 2 : ((u.pn >= 4 && u.pn < 8) ? 1 : 0);
        EPI_ROWS_BEGIN
            bf16* rowp = Z + (size_t)(u.pm * 256 + r) * IN_COLS + col0;
#pragma unroll
            for (int bj = 0; bj < 2; ++bj) { f32x4 v0 = acc[ai][bj][m][0], v1 = acc[ai][bj][m][1];
                if (kind == 1) {
#pragma unroll
                    for (int j = 0; j < 4; ++j) { v0[j] = gelu_tanh(v0[j]); v1[j] = gelu_tanh(v1[j]); } }
                else if (kind == 2) {
#pragma unroll
                    for (int j = 0; j < 4; ++j) { v0[j] = fsigmoid(v0[j]); v1[j] = fsigmoid(v1[j]); } }
                u32x4 w; w.x = g8::cvt_pk_bf16(v0[0], v0[1]); w.y = g8::cvt_pk_bf16(v0[2], v0[3]); w.z = g8::cvt_pk_bf16(v1[0], v1[1]); w.w = g8::cvt_pk_bf16(v1[2], v1[3]);
                *(u32x4*)(rowp + bj * 128) = w; }
        EPI_ROWS_END
    }
};
struct EpiP1 { static constexpr bool AFTER_DRAIN = false; EpiZ z; EpiPlain w2;
    __device__ __forceinline__ void operator()(const f32x4 (&acc)[2][2][4][2], const GU& u, int wr, int wc, int fr, int fq) const { if (u.nt == 4) w2(acc, u, wr, wc, fr, fq); else z(acc, u, wr, wc, fr, fq); }
};
__device__ __forceinline__ void unpack8(const u32x4 w, float (&f)[8]) { f[0] = bflo(w.x); f[1] = bfhi(w.x); f[2] = bflo(w.y); f[3] = bfhi(w.y); f[4] = bflo(w.z); f[5] = bfhi(w.z); f[6] = bflo(w.w); f[7] = bfhi(w.w); }
struct EpiU { static constexpr bool AFTER_DRAIN = false;
    bf16* U; const bf16* Z;
    __device__ __forceinline__ void operator()(const f32x4 (&acc)[2][2][4][2], const GU& u, int wr, int wc, int fr, int fq) const {
        const int col0 = u.pn * 256 + wc * 32 + 8 * fq; const int gcol = (u.aux ? 5120 : 3072) + col0;
        EPI_ROWS_BEGIN
            const size_t row = (size_t)(u.pm * 256 + r);
#pragma unroll
            for (int bj = 0; bj < 2; ++bj) {
                float g[8], p[8]; unpack8(*(const u32x4*)(Z + row * IN_COLS + gcol + bj * 128), g);
                const f32x4 v0 = acc[ai][bj][m][0], v1 = acc[ai][bj][m][1];
                float o[8];
#pragma unroll
                for (int j = 0; j < 4; ++j) { o[j] = v0[j] * g[j]; o[4 + j] = v1[j] * g[4 + j]; }
                bf16* up = U + row * D + col0 + bj * 128;
                if (u.aux) { unpack8(*(const u32x4*)up, p);
#pragma unroll
                    for (int j = 0; j < 8; ++j) o[j] += p[j]; }
                u32x4 w; w.x = g8::cvt_pk_bf16(o[0], o[1]); w.y = g8::cvt_pk_bf16(o[2], o[3]); w.z = g8::cvt_pk_bf16(o[4], o[5]); w.w = g8::cvt_pk_bf16(o[6], o[7]);
                *(u32x4*)up = w; }
        EPI_ROWS_END
    }
};
struct EpiX1 { static constexpr bool AFTER_DRAIN = false;
    const float* x; bf16* X1B;
    __device__ __forceinline__ void operator()(const f32x4 (&acc)[2][2][4][2], const GU& u, int wr, int wc, int fr, int fq) const {
        const int col0 = u.pn * 256 + wc * 32 + 8 * fq;
        EPI_ROWS_BEGIN
            const size_t off = (size_t)(u.pm * 256 + r) * D + col0;
#pragma unroll
            for (int bj = 0; bj < 2; ++bj) {
                const f32x4 a0 = *(const f32x4*)(x + off + bj * 128), a1 = *(const f32x4*)(x + off + bj * 128 + 4);
                const f32x4 v0 = acc[ai][bj][m][0] + a0, v1 = acc[ai][bj][m][1] + a1;
                u32x4 w; w.x = g8::cvt_pk_bf16(v0[0], v0[1]); w.y = g8::cvt_pk_bf16(v0[2], v0[3]); w.z = g8::cvt_pk_bf16(v1[0], v1[1]); w.w = g8::cvt_pk_bf16(v1[2], v1[3]);
                *(u32x4*)(X1B + off + bj * 128) = w; }
        EPI_ROWS_END
    }
};
struct EpiAct { static constexpr bool AFTER_DRAIN = false;
    bf16* ACT; const float* rstd2;
    __device__ __forceinline__ void operator()(const f32x4 (&acc)[2][2][4][2], const GU& u, int wr, int wc, int fr, int fq) const {
        const int col0 = u.pn * 128 + wc * 32 + 8 * fq;
        EPI_ROWS_BEGIN
            int tok = 0; if (r < u.gn) tok = u.gl[r] >> 1;
            const float rs = rstd2[tok];
            const f32x4 g0 = acc[ai][0][m][0] * rs, g1 = acc[ai][0][m][1] * rs, u0 = acc[ai][1][m][0] * rs, u1 = acc[ai][1][m][1] * rs;
            float o[8];
#pragma unroll
            for (int j = 0; j < 4; ++j) { o[j] = g0[j] * fsigmoid(g0[j]) * u0[j]; o[4 + j] = g1[j] * fsigmoid(g1[j]) * u1[j]; }
            u32x4 w; w.x = g8::cvt_pk_bf16(o[0], o[1]); w.y = g8::cvt_pk_bf16(o[2], o[3]); w.z = g8::cvt_pk_bf16(o[4], o[5]); w.w = g8::cvt_pk_bf16(o[6], o[7]);
            *(u32x4*)(ACT + (size_t)(u.pm * 256 + r) * DE + col0) = w;
        EPI_ROWS_END
    }
};
struct EpiDown { static constexpr bool AFTER_DRAIN = false;
    bf16* YS; const int* list; const float* wl;
    __device__ __forceinline__ void operator()(const f32x4 (&acc)[2][2][4][2], const GU& u, int wr, int wc, int fr, int fq) const {
        const int col0 = u.pn * 256 + wc * 32 + 8 * fq;
        EPI_ROWS_BEGIN
            if (r < u.gn) {
                const int ent = list[u.aux + r]; const float w8 = wl[u.aux + r];
                bf16* rowp = YS + ((size_t)(ent & 1) * T + (size_t)(ent >> 1)) * D + col0;
#pragma unroll
                for (int bj = 0; bj < 2; ++bj) { const f32x4 v0 = acc[ai][bj][m][0] * w8, v1 = acc[ai][bj][m][1] * w8;
                    u32x4 w; w.x = g8::cvt_pk_bf16(v0[0], v0[1]); w.y = g8::cvt_pk_bf16(v0[2], v0[3]); w.z = g8::cvt_pk_bf16(v1[0], v1[1]); w.w = g8::cvt_pk_bf16(v1[2], v1[3]);
                    *(u32x4*)(rowp + bj * 128) = w; }
            }
        EPI_ROWS_END
    }
};
struct EpiPle { static constexpr bool AFTER_DRAIN = false;
    float* X3; const bf16* X2B; const bf16* E; const float* rstdp;
    __device__ __forceinline__ void operator()(const f32x4 (&acc)[2][2][4][2], const GU& u, int wr, int wc, int fr, int fq) const {
        const int col0 = u.pn * 256 + wc * 32 + 8 * fq;
        EPI_ROWS_BEGIN
            const size_t row = (size_t)(u.pm * 256 + r), off = row * D + col0; const float rs = rstdp[row];
#pragma unroll
            for (int bj = 0; bj < 2; ++bj) {
                float x2[8], e[8]; unpack8(*(const u32x4*)(X2B + off + bj * 128), x2); unpack8(*(const u32x4*)(E + off + bj * 128), e);
                const f32x4 v0 = acc[ai][bj][m][0] * rs, v1 = acc[ai][bj][m][1] * rs; f32x4 o0, o1;
#pragma unroll
                for (int j = 0; j < 4; ++j) { o0[j] = x2[j] + fsigmoid(v0[j]) * e[j]; o1[j] = x2[4 + j] + fsigmoid(v1[j]) * e[4 + j]; }
                *(f32x4*)(X3 + off + bj * 128) = o0; *(f32x4*)(X3 + off + bj * 128 + 4) = o1; }
        EPI_ROWS_END
    }
};


constexpr size_t MI_XS = 786432;
constexpr int CW_PAN = 16384;
struct EpiPleF { static constexpr bool AFTER_DRAIN = true;
    float* OUT; const bf16* X2B; const bf16* E; const float* rstdp; const float* gfin; float* xs; unsigned* cnt;
    __device__ __forceinline__ void operator()(const f32x4 (&)[2][2][4][2], const GU&, int, int, int, int) const {}
    __device__ __forceinline__ void fused(f32x4 (&acc)[2][2][4][2], const GU& u, int wr, int wc, int fr, int fq, LAS unsigned char* lds, int wid, int lane) const {
        const int col0 = u.pn * 256 + wc * 32 + 8 * fq, tid = wid * 64 + lane;
        LAS float* P = (LAS float*)lds;
        LAS float* S = (LAS float*)(lds + 8192);
        EPI_ROWS_BEGIN
            const size_t row = (size_t)(u.pm * 256 + r), off = row * D + col0; const float rs = rstdp[row]; float ss = 0.f;
#pragma unroll
            for (int bj = 0; bj < 2; ++bj) {
                float x2[8], e[8]; unpack8(*(const u32x4*)(X2B + off + bj * 128), x2); unpack8(*(const u32x4*)(E + off + bj * 128), e);
#pragma unroll
                for (int n = 0; n < 2; ++n)
#pragma unroll
                    for (int j = 0; j < 4; ++j) { const float v = x2[4 * n + j] + fsigmoid(acc[ai][bj][m][n][j] * rs) * e[4 * n + j]; acc[ai][bj][m][n][j] = v; ss += v * v; }
            }
            ss += __shfl_xor(ss, 16); ss += __shfl_xor(ss, 32);
            if (fq == 0) P[r * 4 + wc] = ss;
        EPI_ROWS_END
        asm volatile("s_waitcnt lgkmcnt(0)" ::: "memory"); __builtin_amdgcn_s_barrier(); asm volatile("" ::: "memory");
        if (tid < 256) {
            const float t = (P[tid * 4 + 0] + P[tid * 4 + 1]) + (P[tid * 4 + 2] + P[tid * 4 + 3]);
            __hip_atomic_store(xs + (size_t)(u.pm * 256 + tid) * 8 + u.pn, t, RLX_AGENT);
            asm volatile("s_waitcnt vmcnt(0)" ::: "memory");
            if (lane == 0) __hip_atomic_fetch_add(cnt + 64 * u.pm, 1u, RLX_AGENT);
        }
        if (wid == 0) {
            unsigned sp = 0;
            while ((unsigned)__builtin_amdgcn_readfirstlane(__hip_atomic_load(cnt + 64 * u.pm, RLX_AGENT)) < 32u) { __builtin_amdgcn_s_sleep(2); if (++sp > (1u << 22)) break; }
            __builtin_amdgcn_fence(__ATOMIC_ACQUIRE, "agent");
        }
        asm volatile("s_waitcnt vmcnt(0) lgkmcnt(0)" ::: "memory"); __builtin_amdgcn_s_barrier(); asm volatile("" ::: "memory");
        if (tid < 256) {
            const float* sl = xs + (size_t)(u.pm * 256 + tid) * 8; float t = 0.f;
#pragma unroll
            for (int k = 0; k < 8; ++k) t += __hip_atomic_load(sl + k, RLX_AGENT);
            S[tid] = 1.0f / sqrtf(t * (1.0f / D) + EPS);
        }
        asm volatile("s_waitcnt lgkmcnt(0)" ::: "memory"); __builtin_amdgcn_s_barrier(); asm volatile("" ::: "memory");
        f32x4 g[2][2];
#pragma unroll
        for (int bj = 0; bj < 2; ++bj) { g[bj][0] = *(const f32x4*)(gfin + col0 + bj * 128); g[bj][1] = *(const f32x4*)(gfin + col0 + bj * 128 + 4); }
        EPI_ROWS_BEGIN
            const float rstd = S[r]; float* op = OUT + (size_t)(u.pm * 256 + r) * D + col0;
#pragma unroll
            for (int bj = 0; bj < 2; ++bj) { *(f32x4*)(op + bj * 128) = acc[ai][bj][m][0] * rstd * g[bj][0]; *(f32x4*)(op + bj * 128 + 4) = acc[ai][bj][m][1] * rstd * g[bj][1]; }
        EPI_ROWS_END
    }
};

constexpr int CW_DONE = 8192;
struct SchedMoe {
    const char* wsb; const volatile LAS int* ts;
    int G, c, nup, nupc, nfree, rank, nE;
    __device__ __forceinline__ void init(int G_, int c_, int ntile) {
        G = G_; c = c_; nup = 4 * ntile; nupc = (nup > c) ? (nup - c + G - 1) / G : 0;
        int n2 = nup - G; n2 = n2 < 0 ? 0 : (n2 > G ? G : n2); nfree = G - n2; rank = c - n2; if (nfree <= 0) { nfree = G; rank = c; }
        nE = (rank >= 0 && rank < 256) ? (256 - rank + nfree - 1) / nfree : 0;
    }
    __device__ __forceinline__ void expert_of(int rt, int& e, int& i0, int& gn) const {
        e = 0;
#pragma unroll
        for (int j = 1; j < 16; ++j) e += (rt >= ts[j]) ? 1 : 0;
        e = __builtin_amdgcn_readfirstlane(e); i0 = __builtin_amdgcn_readfirstlane(rt - ts[e]); gn = __builtin_amdgcn_readfirstlane(((const int*)(wsb + WS_CTL))[CW_CNT + e]) - 256 * i0; gn = gn > 256 ? 256 : gn;
    }
    __device__ __forceinline__ bool next(int i, GU& u) const {
        const char* X = wsb + WS_YD; const char* WGU = wsb + WS_WGU; const char* ACT = wsb + WS_ACT; const char* WD = wsb + WS_WD; const char* PB = wsb + WS_PB; const char* WPP = wsb + WS_WPP; const int* list = (const int*)(wsb + WS_LIST);
        if (i < nupc) { const int L = i * G + c, rt = L >> 2, pn = L & 3; int e, i0, gn; expert_of(rt, e, i0, gn);
            u.A = X; u.gl = list + e * T + 256 * i0; u.gn = gn; u.lda = 4096; u.B = WGU + ((size_t)e * 1024 + 256 * pn) * 4096; u.nt = 32; u.pm = rt; u.pn = pn; u.aux = e; return true; }
        if (rank < 0) return false;
        int j = i - nupc;
        if (j < nE) { const int L = rank + j * nfree; g8::tile_of(L, 32, 8, u.pm, u.pn); u.A = PB + (size_t)u.pm * 256 * 512; u.B = WPP + (size_t)u.pn * 256 * 512; u.gl = nullptr; u.gn = 0; u.lda = 512; u.nt = 4; u.aux = 0; return true; }
        j -= nE; const int L = rank + j * nfree; if (L >= 2 * nup) return false;
        const int rt = L >> 3, pn = L & 7; int e, i0, gn; expert_of(rt, e, i0, gn);
        u.A = ACT + (size_t)rt * 256 * 1024; u.gl = nullptr; u.gn = gn; u.lda = 1024; u.B = WD + ((size_t)e * 2048 + 256 * pn) * 1024; u.nt = 8; u.pm = rt; u.pn = pn; u.aux = e * T + 256 * i0; return true;
    }
    __device__ __forceinline__ void a_ready(const GU& u, int wid) const {
        if (u.nt != 8) return;
        if (wid == 0) {
            unsigned* w = (unsigned*)(wsb + WS_CTL) + CW_DONE + 64 * u.pm; unsigned sp = 0;
            while ((unsigned)__builtin_amdgcn_readfirstlane(__hip_atomic_load(w, RLX_AGENT)) < 32u) { __builtin_amdgcn_s_sleep(2); if (++sp > (1u << 22)) break; }
            __builtin_amdgcn_fence(__ATOMIC_ACQUIRE, "agent");
            asm volatile("s_waitcnt vmcnt(0)" ::: "memory");
        }
        asm volatile("" ::: "memory"); __builtin_amdgcn_s_barrier(); asm volatile("" ::: "memory");
    }
    __device__ __forceinline__ void done(const GU& u, int lane) const {
        if (u.nt != 32) return;
        asm volatile("s_waitcnt vmcnt(0)" ::: "memory");
        if (lane == 0) __hip_atomic_fetch_add((unsigned*)(wsb + WS_CTL) + CW_DONE + 64 * u.pm, 1u, RLX_AGENT);
    }
};
struct EpiMoe { static constexpr bool AFTER_DRAIN = false;
    unsigned char* wsb;
    __device__ __forceinline__ void operator()(const f32x4 (&acc)[2][2][4][2], const GU& u, int wr, int wc, int fr, int fq) const {
        bf16* ACT = (bf16*)(wsb + WS_ACT); const float* rstd2 = (const float*)(wsb + WS_MISC + MI_RSTD2); bf16* YS = (bf16*)(wsb + WS_YS); const int* list = (const int*)(wsb + WS_LIST); const float* wl = (const float*)(wsb + WS_WL); bf16* Eo = (bf16*)(wsb + WS_XN);
        if (u.nt == 32) {
            const __amdgpu_buffer_rsrc_t rs_ = __builtin_amdgcn_make_buffer_rsrc(ACT, 0, (int)((2 * T + 4096) * DE * 2), 0x00020000);
            const int col0 = u.pn * 128 + wc * 32 + 8 * fq;
            EPI_ROWS_BEGIN
                int tok = 0; if (r < u.gn) tok = u.gl[r] >> 1;
                const float rs = rstd2[tok];
                const f32x4 g0 = acc[ai][0][m][0] * rs, g1 = acc[ai][0][m][1] * rs, u0 = acc[ai][1][m][0] * rs, u1 = acc[ai][1][m][1] * rs;
                float o[8];
#pragma unroll
                for (int j = 0; j < 4; ++j) { o[j] = g0[j] * fsigmoid(g0[j]) * u0[j]; o[4 + j] = g1[j] * fsigmoid(g1[j]) * u1[j]; }
                u32x4 w; w.x = g8::cvt_pk_bf16(o[0], o[1]); w.y = g8::cvt_pk_bf16(o[2], o[3]); w.z = g8::cvt_pk_bf16(o[4], o[5]); w.w = g8::cvt_pk_bf16(o[6], o[7]);
                __builtin_amdgcn_raw_buffer_store_b128(w, rs_, (unsigned)(((size_t)(u.pm * 256 + r) * DE + col0) * 2), 0, 16);
            EPI_ROWS_END
        } else if (u.nt == 8) {
            const int col0 = u.pn * 256 + wc * 32 + 8 * fq;
            EPI_ROWS_BEGIN
                if (r < u.gn) {
                    const int ent = list[u.aux + r]; const float w8 = wl[u.aux + r];
                    bf16* rowp = YS + ((size_t)(ent & 1) * T + (size_t)(ent >> 1)) * D + col0;
#pragma unroll
                    for (int bj = 0; bj < 2; ++bj) { const f32x4 v0 = acc[ai][bj][m][0] * w8, v1 = acc[ai][bj][m][1] * w8;
                        u32x4 w; w.x = g8::cvt_pk_bf16(v0[0], v0[1]); w.y = g8::cvt_pk_bf16(v0[2], v0[3]); w.z = g8::cvt_pk_bf16(v1[0], v1[1]); w.w = g8::cvt_pk_bf16(v1[2], v1[3]);
                        *(u32x4*)(rowp + bj * 128) = w; }
                }
            EPI_ROWS_END
        } else {
            const int col0 = u.pn * 256 + wc * 32 + 8 * fq;
            EPI_ROWS_BEGIN
                bf16* rowp = Eo + (size_t)(u.pm * 256 + r) * D + col0;
#pragma unroll
                for (int bj = 0; bj < 2; ++bj) { const f32x4 v0 = acc[ai][bj][m][0], v1 = acc[ai][bj][m][1];
                    u32x4 w; w.x = g8::cvt_pk_bf16(v0[0], v0[1]); w.y = g8::cvt_pk_bf16(v0[2], v0[3]); w.z = g8::cvt_pk_bf16(v1[0], v1[1]); w.w = g8::cvt_pk_bf16(v1[2], v1[3]);
                    *(u32x4*)(rowp + bj * 128) = w; }
            EPI_ROWS_END
        }
    }
};

constexpr int P2_BFR = 0, P2_CST = 24576, P2_WT = 26624, P2_HS = 30720, P2_IO = 32768, P2_IOW = 9216, P2_ROW = 144;
__device__ __forceinline__ float neg_expm1(float x) {
    const float p = x * (1.0f + x * (0.5f + x * (0.16666667f + x * (0.041666668f + x * (0.0083333338f + x * 0.0013888889f)))));
    const float q = 1.0f - __expf(x);
    return (x > -0.25f) ? -p : q;
}
__device__ __forceinline__ void p2_lru_item(Frame& F, unsigned char* ws, int item) {
    const bf16* Z = (const bf16*)(ws + WS_Z); bf16* YD = (bf16*)(ws + WS_YD);
    const int lane = F.lane, wave = F.wave, tid = F.tid, fr = lane & 15, fq = lane >> 4;
    const int c = item >> 6, bh = item & 63, b = bh >> 4, h = bh & 15;
    const int tw = b * SEQ + c * 256 + 32 * wave, sw = c * 256 + 32 * wave;
    LAS unsigned char* L = F.lds;
    __syncthreads();
    {
        const u32x4* src = (const u32x4*)(ws + WS_MISC + MI_WRG) + (size_t)h * 24 * 64;
#pragma unroll
        for (int k = 0; k < 3; ++k) *(LAS u32x4*)(L + P2_BFR + (tid + 512 * k) * 16) = src[tid + 512 * k];
        if (tid < 128) *(LAS u32x4*)(L + P2_CST + tid * 16) = ((const u32x4*)(ws + WS_MISC + MI_CST) + (size_t)h * 128)[tid];
    }
    LAS unsigned char* GG = L + P2_IO + wave * P2_IOW; LAS unsigned char* YT = GG + 32 * P2_ROW;
#pragma unroll
    for (int k = 0; k < 4; ++k) { const int p = lane + 64 * k, row = p >> 3, c8 = p & 7;
        *(LAS u32x4*)(GG + row * P2_ROW + c8 * 16) = *(const u32x4*)(Z + (size_t)(tw + row) * IN_COLS + 1024 + 64 * h + 8 * c8); }
    __syncthreads();
    const LAS float* CS = (const LAS float*)(L + P2_CST);
    float ba4[4], bx4[4], sp4[4];
#pragma unroll
    for (int n = 0; n < 4; ++n) { ba4[n] = CS[5 * 64 + 16 * n + fr]; bx4[n] = CS[6 * 64 + 16 * n + fr]; sp4[n] = CS[7 * 64 + 16 * n + fr]; }
    float cA[4] = {1.f, 1.f, 1.f, 1.f}, cH[4] = {0.f, 0.f, 0.f, 0.f};
    float Ac[2][4][4], Hl[2][4][4];
#pragma unroll
    for (int rt = 0; rt < 2; ++rt) {
        bf16x8 af[2];
#pragma unroll
        for (int sx = 0; sx < 2; ++sx) {
            const int k0 = 32 * sx + 8 * fq; float xa[8];
            { const f32x4 c0 = *(const LAS f32x4*)(CS + 4 * 64 + k0), c1 = *(const LAS f32x4*)(CS + 4 * 64 + k0 + 4);
#pragma unroll
              for (int j = 0; j < 4; ++j) { xa[j] = c0[j]; xa[4 + j] = c1[j]; } }
#pragma unroll
            for (int q = 0; q < 4; ++q) {
                const int dpos = 16 * rt + fr + q - 3; const bool ok = (sw + dpos) >= 0; const int drow = ok ? dpos : 0;
                float xv[8]; unpack8(*(const u32x4*)(Z + (size_t)(tw + drow) * IN_COLS + 64 * h + k0), xv);
                const f32x4 w0 = *(const LAS f32x4*)(CS + q * 64 + k0), w1 = *(const LAS f32x4*)(CS + q * 64 + k0 + 4); const float mk = ok ? 1.f : 0.f;
#pragma unroll
                for (int j = 0; j < 4; ++j) { xa[j] += w0[j] * (xv[j] * mk); xa[4 + j] += w1[j] * (xv[4 + j] * mk); }
            }
            u32x4 pk; pk.x = pk2(xa[0], xa[1]); pk.y = pk2(xa[2], xa[3]); pk.z = pk2(xa[4], xa[5]); pk.w = pk2(xa[6], xa[7]);
            af[sx] = __builtin_bit_cast(bf16x8, pk);
            __builtin_amdgcn_sched_barrier(0);
        }
        __builtin_amdgcn_sched_barrier(0);
#pragma unroll
        for (int n = 0; n < 4; ++n) {
            f32x4 Dm[3];
#pragma unroll
            for (int q = 0; q < 3; ++q) { Dm[q] = (f32x4){0.f, 0.f, 0.f, 0.f};
#pragma unroll
                for (int sx = 0; sx < 2; ++sx) { const bf16x8 bfr = *(const LAS bf16x8*)(L + P2_BFR + ((4 * q + n) * 2 + sx) * 1024 + lane * 16); Dm[q] = __builtin_amdgcn_mfma_f32_16x16x32_bf16(af[sx], bfr, Dm[q], 0, 0, 0); } }
            float a[4], hh[4];
#pragma unroll
            for (int i = 0; i < 4; ++i) {
                const float r = fsigmoid(Dm[0][i] + ba4[n]), ig = fsigmoid(Dm[1][i] + bx4[n]), xv = Dm[2][i];
                const float la = -r * sp4[n];
                a[i] = __expf(la); hh[i] = sqrtf(neg_expm1(2.0f * la)) * ig * xv;
            }
#pragma unroll
            for (int i = 1; i < 4; ++i) { hh[i] = a[i] * hh[i - 1] + hh[i]; a[i] = a[i] * a[i - 1]; }
            float XA = a[3], XH = hh[3];
            { const float pa = __shfl_up(XA, 16), ph = __shfl_up(XH, 16); if (fq >= 1) { XH = XA * ph + XH; XA = XA * pa; } }
            { const float pa = __shfl_up(XA, 32), ph = __shfl_up(XH, 32); if (fq >= 2) { XH = XA * ph + XH; XA = XA * pa; } }
            float EA = __shfl_up(XA, 16), EH = __shfl_up(XH, 16); if (fq == 0) { EA = 1.f; EH = 0.f; }
            const float TA = __shfl(XA, 48 + fr), TH = __shfl(XH, 48 + fr);
            const float PA = cA[n] * EA, PH = EA * cH[n] + EH;
#pragma unroll
            for (int i = 0; i < 4; ++i) { Ac[rt][n][i] = PA * a[i]; Hl[rt][n][i] = a[i] * PH + hh[i]; }
            cH[n] = TA * cH[n] + TH; cA[n] = cA[n] * TA;
            __builtin_amdgcn_sched_barrier(0);
        }
    }
    if (fq == 0) {
#pragma unroll
        for (int n = 0; n < 4; ++n) *(LAS f32x2*)(L + P2_WT + (wave * 64 + 16 * n + fr) * 8) = (f32x2){cA[n], cH[n]};
    }
    __syncthreads();
    if (wave == 0) {
        unsigned long long* GR = (unsigned long long*)(ws + WS_CTL + CTL_GRAN);
        float hin = 0.f;
        if (c > 0) {
            unsigned long long* g = GR + ((size_t)(bh * 8 + c - 1) * 64 + lane); unsigned sp = 0; unsigned long long v;
            for (;;) { v = __hip_atomic_load(g, RLX_AGENT); if (__all((unsigned)(v >> 32) == 1u)) break; __builtin_amdgcn_s_sleep(1); if (++sp > (1u << 22)) break; }
            hin = __builtin_bit_cast(float, (unsigned)v);
        }
        float hcur = hin;
#pragma unroll
        for (int w = 0; w < 8; ++w) { *(LAS float*)(L + P2_HS + (w * 64 + lane) * 4) = hcur; const f32x2 t = *(const LAS f32x2*)(L + P2_WT + (w * 64 + lane) * 8); hcur = t.x * hcur + t.y; }
        __hip_atomic_store(GR + ((size_t)(bh * 8 + c) * 64 + lane), (1ull << 32) | (unsigned long long)__builtin_bit_cast(unsigned, hcur), RLX_AGENT);
    }
    __syncthreads();
    float hs[4];
#pragma unroll
    for (int n = 0; n < 4; ++n) hs[n] = *(const LAS float*)(L + P2_HS + (wave * 64 + 16 * n + fr) * 4);
#pragma unroll
    for (int rt = 0; rt < 2; ++rt)
#pragma unroll
        for (int n = 0; n < 4; ++n)
#pragma unroll
            for (int i = 0; i < 4; ++i) { const int row = 16 * rt + 4 * fq + i, col = 16 * n + fr;
                const float g = bf2f(*(const LAS unsigned short*)(GG + row * P2_ROW + col * 2));
                *(LAS unsigned short*)(YT + row * P2_ROW + col * 2) = (unsigned short)f2bf((Hl[rt][n][i] + Ac[rt][n][i] * hs[n]) * g); }
    LDS_WAIT();
#pragma unroll
    for (int k = 0; k < 4; ++k) { const int p = lane + 64 * k, row = p >> 3, c8 = p & 7;
        *(u32x4*)(YD + (size_t)(tw + row) * D + 64 * h + 8 * c8) = *(const LAS u32x4*)(YT + row * P2_ROW + c8 * 16); }
}
__device__ __forceinline__ void p2_pool_item(Frame& F, unsigned char* ws, int blk) {
    const bf16* Z = (const bf16*)(ws + WS_Z); bf16* YD = (bf16*)(ws + WS_YD);
    const int tid = F.tid, g = (2 * tid) >> 8, w = 2 << g, tb = blk * 64, s0p = tb % SEQ;
    const unsigned* zc = (const unsigned*)(Z + 2048 + 2 * tid);
    float s0 = 0.f, s1 = 0.f;
    for (int k = 1; k <= w; ++k) if (s0p - k >= 0) { const unsigned v = zc[(size_t)(tb - k) * (IN_COLS / 2)]; s0 += bflo(v); s1 += bfhi(v); }
    for (int tt = 0; tt < 64; ++tt) {
        const unsigned v = zc[(size_t)(tb + tt) * (IN_COLS / 2)]; const float x0 = bflo(v), x1 = bfhi(v); s0 += x0; s1 += x1;
        const int pos = s0p + tt; if (pos - w >= 0) { const unsigned vo = zc[(size_t)(tb + tt - w) * (IN_COLS / 2)]; s0 -= bflo(vo); s1 -= bfhi(vo); }
        const float inv = 1.0f / (float)((pos + 1) < w ? (pos + 1) : w);
        *(unsigned*)(YD + (size_t)(tb + tt) * D + 1024 + 2 * tid) = pk2(s0 * inv - x0, s1 * inv - x1);
    }
}
__device__ __forceinline__ void p2_fast(Frame& F) {
    unsigned char* ws = WSP;
    for (int item = (int)blockIdx.x; item < 512 + 128; item += F.G) { if (item < 512) p2_lru_item(F, ws, item); else p2_pool_item(F, ws, item - 512); }
}

__device__ __forceinline__ void p5_router(Frame& F) {
    unsigned char* ws = WSP; const float* X1 = OUTP; const float* g2 = INP(16); const float* wg = INP(17); const float* bg = INP(18); const float* we = INP(19); const float* be = INP(20);
    float* rstd2 = (float*)(ws + WS_MISC + MI_RSTD2); int* list = (int*)(ws + WS_LIST); float* wl = (float*)(ws + WS_WL); unsigned* cnt = (unsigned*)(ws + WS_CTL) + CW_CNT;
    const int gw = F.vcu * NWAVES + F.wave, NGW = F.G * NWAVES;
    for (int t = gw; t < T; t += NGW) {
        const f32x4* xr = (const f32x4*)(X1 + (size_t)t * D) + F.lane; const f32x4* gr = (const f32x4*)g2 + F.lane;
        f32x4 v[8]; float s = 0.f;
#pragma unroll
        for (int j = 0; j < 8; ++j) { v[j] = xr[64 * j]; s += (v[j].x * v[j].x + v[j].y * v[j].y) + (v[j].z * v[j].z + v[j].w * v[j].w); }
        const float rstd = 1.f / sqrtf(wave_sum(s) * (1.f / D) + EPS);
        float lg[4] = {0.f, 0.f, 0.f, 0.f}, le[16];
#pragma unroll
        for (int j = 0; j < 16; ++j) le[j] = 0.f;
#pragma unroll
        for (int j = 0; j < 8; ++j) { const f32x4 g = gr[64 * j]; const int k0 = 4 * (F.lane + 64 * j);
#pragma unroll
            for (int q = 0; q < 4; ++q) { const float hv = v[j][q] * rstd * g[q]; const f32x4 w4 = *(const f32x4*)(wg + (size_t)(k0 + q) * 4);
#pragma unroll
                for (int c = 0; c < 4; ++c) lg[c] += hv * w4[c];
#pragma unroll
                for (int c4 = 0; c4 < 4; ++c4) { const f32x4 w16 = *(const f32x4*)(we + (size_t)(k0 + q) * 16 + 4 * c4);
#pragma unroll
                    for (int c = 0; c < 4; ++c) le[4 * c4 + c] += hv * w16[c]; } } }
#pragma unroll
        for (int j = 0; j < 4; ++j) lg[j] = wave_sum(lg[j]) + bg[j];
#pragma unroll
        for (int j = 0; j < 16; ++j) le[j] = wave_sum(le[j]) + be[j];
        if (F.lane == 0) {
            int gi = 0; float gm = lg[0];
#pragma unroll
            for (int j = 1; j < 4; ++j) if (lg[j] > gm) { gm = lg[j]; gi = j; }
            float gs = 0.f;
#pragma unroll
            for (int j = 0; j < 4; ++j) gs += expf(lg[j] - gm);
            const float g_w = 1.f / gs;
            float ls[4];
#pragma unroll
            for (int j = 0; j < 4; ++j) { float vv = le[j];
#pragma unroll
                for (int g = 1; g < 4; ++g) if (gi == g) vv = le[g * 4 + j];
                ls[j] = vv; }
            float mx = ls[0];
#pragma unroll
            for (int j = 1; j < 4; ++j) mx = fmaxf(mx, ls[j]);
            float pe[4], ps = 0.f;
#pragma unroll
            for (int j = 0; j < 4; ++j) { pe[j] = expf(ls[j] - mx); ps += pe[j]; }
#pragma unroll
            for (int j = 0; j < 4; ++j) pe[j] /= ps;
            float v0 = -1.f; int i0 = 0;
#pragma unroll
            for (int j = 0; j < 4; ++j) if (pe[j] > v0) { v0 = pe[j]; i0 = j; }
            float v1 = -1.f; int i1 = 0;
#pragma unroll
            for (int j = 0; j < 4; ++j) if (j != i0 && pe[j] > v1) { v1 = pe[j]; i1 = j; }
            const float sv = v0 + v1; const int e0 = gi * 4 + i0, e1 = gi * 4 + i1;
            rstd2[t] = rstd;
            const unsigned p0 = __hip_atomic_fetch_add(cnt + e0, 1u, RLX_AGENT), p1 = __hip_atomic_fetch_add(cnt + e1, 1u, RLX_AGENT);
            list[e0 * T + p0] = t * 2; wl[e0 * T + p0] = g_w * v0 / sv; list[e1 * T + p1] = t * 2 + 1; wl[e1 * T + p1] = g_w * v1 / sv;
        }
    }
}

constexpr int P5_PL = 0, P5_SS = 32768, P5_LG = 36864, P5_RS = 40960;
__device__ __forceinline__ void p5_fast(Frame& F) {
    unsigned char* ws = WSP; const bf16* X1B = (const bf16*)(ws + WS_YD); const float* bg = INP(18); const float* be = INP(20);
    float* rstd2 = (float*)(ws + WS_MISC + MI_RSTD2); int* list = (int*)(ws + WS_LIST); float* wl = (float*)(ws + WS_WL); unsigned* cnt = (unsigned*)(ws + WS_CTL) + CW_CNT;
    const u32x4* WRT = (const u32x4*)(ws + WS_MISC + MI_WRT);
    const int lane = F.lane, wave = F.wave, tid = F.tid, fr = lane & 15, fq = lane >> 4; LAS unsigned char* L = F.lds;
    for (int item = (int)blockIdx.x; item < T / 32; item += F.G) {
        const int r0 = item * 32;
        f32x4 acc[2][2]; float ss[2] = {0.f, 0.f};
#pragma unroll
        for (int rt = 0; rt < 2; ++rt)
#pragma unroll
            for (int nt = 0; nt < 2; ++nt) acc[rt][nt] = (f32x4){0.f, 0.f, 0.f, 0.f};
#pragma unroll 2
        for (int kk = 0; kk < 8; ++kk) {
            const int ks = wave * 8 + kk;
            bf16x8 bh[2], bl[2];
#pragma unroll
            for (int nt = 0; nt < 2; ++nt) { const u32x4* p = WRT + ((size_t)(ks * 2 + nt) * 2) * 64 + lane; bh[nt] = __builtin_bit_cast(bf16x8, p[0]); bl[nt] = __builtin_bit_cast(bf16x8, p[64]); }
#pragma unroll
            for (int rt = 0; rt < 2; ++rt) {
                const u32x4 xw = *(const u32x4*)(X1B + (size_t)(r0 + 16 * rt + fr) * D + 32 * ks + 8 * fq);
                float v[8]; unpack8(xw, v);
#pragma unroll
                for (int j = 0; j < 8; ++j) ss[rt] += v[j] * v[j];
                const bf16x8 ah = __builtin_bit_cast(bf16x8, xw);
#pragma unroll
                for (int nt = 0; nt < 2; ++nt) {
                    acc[rt][nt] = __builtin_amdgcn_mfma_f32_16x16x32_bf16(ah, bh[nt], acc[rt][nt], 0, 0, 0);
                    acc[rt][nt] = __builtin_amdgcn_mfma_f32_16x16x32_bf16(ah, bl[nt], acc[rt][nt], 0, 0, 0);
                }
            }
        }
        __syncthreads();
#pragma unroll
        for (int rt = 0; rt < 2; ++rt) {
#pragma unroll
            for (int nt = 0; nt < 2; ++nt)
#pragma unroll
                for (int i = 0; i < 4; ++i) *(LAS float*)(L + P5_PL + ((wave * 32 + 16 * rt + 4 * fq + i) * 32 + 16 * nt + fr) * 4) = acc[rt][nt][i];
            float s = ss[rt]; s += __shfl_xor(s, 16); s += __shfl_xor(s, 32);
            if (fq == 0) *(LAS float*)(L + P5_SS + (wave * 32 + 16 * rt + fr) * 4) = s;
        }
        __syncthreads();
        {
            const int row = tid >> 4, col = tid & 15; float a0 = 0.f, a1 = 0.f;
#pragma unroll
            for (int w = 0; w < 8; ++w) { a0 += *(const LAS float*)(L + P5_PL + ((w * 32 + row) * 32 + col) * 4); a1 += *(const LAS float*)(L + P5_PL + ((w * 32 + row) * 32 + col + 16) * 4); }
            *(LAS float*)(L + P5_LG + (row * 32 + col) * 4) = a0; *(LAS float*)(L + P5_LG + (row * 32 + col + 16) * 4) = a1;
            if (col == 0) { float s = 0.f;
#pragma unroll
                for (int w = 0; w < 8; ++w) s += *(const LAS float*)(L + P5_SS + (w * 32 + row) * 4);
                *(LAS float*)(L + P5_RS + row * 4) = 1.f / sqrtf(s * (1.f / D) + EPS); }
        }
        __syncthreads();
        if (tid < 32) {
            const int t = r0 + tid; const float rstd = *(const LAS float*)(L + P5_RS + tid * 4); const LAS float* lgp = (const LAS float*)(L + P5_LG + tid * 128);
            float lg[4], le[16];
#pragma unroll
            for (int j = 0; j < 4; ++j) lg[j] = lgp[j] * rstd + bg[j];
#pragma unroll
            for (int j = 0; j < 16; ++j) le[j] = lgp[4 + j] * rstd + be[j];
            int gi = 0; float gm = lg[0];
#pragma unroll
            for (int j = 1; j < 4; ++j) if (lg[j] > gm) { gm = lg[j]; gi = j; }
            float gs = 0.f;
#pragma unroll
            for (int j = 0; j < 4; ++j) gs += expf(lg[j] - gm);
            const float g_w = 1.f / gs;
            float ls[4];
#pragma unroll
            for (int j = 0; j < 4; ++j) { float vv = le[j];
#pragma unroll
                for (int g = 1; g < 4; ++g) if (gi == g) vv = le[g * 4 + j];
                ls[j] = vv; }
            float mx = ls[0];
#pragma unroll
            for (int j = 1; j < 4; ++j) mx = fmaxf(mx, ls[j]);
            float pe[4], ps = 0.f;
#pragma unroll
            for (int j = 0; j < 4; ++j) { pe[j] = expf(ls[j] - mx); ps += pe[j]; }
#pragma unroll
            for (int j = 0; j < 4; ++j) pe[j] /= ps;
            float v0 = -1.f; int i0 = 0;
#pragma unroll
            for (int j = 0; j < 4; ++j) if (pe[j] > v0) { v0 = pe[j]; i0 = j; }
            float v1 = -1.f; int i1 = 0;
#pragma unroll
            for (int j = 0; j < 4; ++j) if (j != i0 && pe[j] > v1) { v1 = pe[j]; i1 = j; }
            const float sv = v0 + v1; const int e0 = gi * 4 + i0, e1 = gi * 4 + i1;
            rstd2[t] = rstd;
            const unsigned p0 = __hip_atomic_fetch_add(cnt + e0, 1u, RLX_AGENT), p1 = __hip_atomic_fetch_add(cnt + e1, 1u, RLX_AGENT);
            list[e0 * T + p0] = t * 2; wl[e0 * T + p0] = g_w * v0 / sv; list[e1 * T + p1] = t * 2 + 1; wl[e1 * T + p1] = g_w * v1 / sv;
        }
    }
}
__device__ __forceinline__ void moe_table(Frame& F, volatile LAS int* ts) {
    if (F.tid == 0) { unsigned* ctl = (unsigned*)(WSP + WS_CTL); int s = 0; for (int e = 0; e < NE; ++e) { ts[e] = s; s += ((int)__hip_atomic_load(ctl + CW_CNT + e, RLX_AGENT) + 255) >> 8; } ts[16] = s; }
    __syncthreads();
}
__device__ __forceinline__ void p8_combine(Frame& F) {
    unsigned char* ws = WSP; const bf16* YS = (const bf16*)(ws + WS_YS); bf16* XB = (bf16*)(ws + WS_YD); float* rstdp = (float*)(ws + WS_MISC + MI_RSTDP);
    const int gw = F.vcu * NWAVES + F.wave, NGW = F.G * NWAVES;
    for (int t = gw; t < T; t += NGW) {
        u32x4* xr = (u32x4*)(XB + (size_t)t * D) + F.lane; const u32x4* y0 = (const u32x4*)(YS + (size_t)t * D) + F.lane; const u32x4* y1 = (const u32x4*)(YS + (size_t)(T + t) * D) + F.lane;
        float s = 0.f;
#pragma unroll
        for (int j = 0; j < 4; ++j) { float a[8], b[8], c[8]; unpack8(xr[64 * j], a); unpack8(y0[64 * j], b); unpack8(y1[64 * j], c);
#pragma unroll
            for (int q = 0; q < 8; ++q) { a[q] += b[q] + c[q]; a[q] = bf2f(f2bf(a[q])); s += a[q] * a[q]; }
            u32x4 o; o.x = pk2(a[0], a[1]); o.y = pk2(a[2], a[3]); o.z = pk2(a[4], a[5]); o.w = pk2(a[6], a[7]); xr[64 * j] = o; }
        s = wave_sum(s);
        if (F.lane == 0) rstdp[t] = 1.f / sqrtf(s * (1.f / D) + EPS);
    }
}
__device__ __forceinline__ void p10_final(Frame& F) {
    const int gw = F.vcu * NWAVES + F.wave, NGW = F.G * NWAVES; float* outp = OUTP; const float* gfin = INP(27);
    for (int t = gw; t < T; t += NGW) {
        f32x4* xr = (f32x4*)(outp + (size_t)t * D) + F.lane; const f32x4* gr = (const f32x4*)gfin + F.lane;
        f32x4 v[8]; float s = 0.f;
#pragma unroll
        for (int j = 0; j < 8; ++j) { v[j] = xr[64 * j]; s += (v[j].x * v[j].x + v[j].y * v[j].y) + (v[j].z * v[j].z + v[j].w * v[j].w); }
        const float rstd = 1.f / sqrtf(wave_sum(s) * (1.f / D) + EPS);
#pragma unroll
        for (int j = 0; j < 8; ++j) { const f32x4 g = gr[64 * j]; xr[64 * j] = v[j] * rstd * g; }
    }
}

constexpr int N_PHASES = 13;
__global__ void __launch_bounds__(NTHREADS, 2) mk_fwd(Args args) {
    extern __shared__ __attribute__((aligned(16))) unsigned char lds_raw[];
    Frame F;
    F.lds = (LAS unsigned char*)lds_raw; F.MISC = (volatile LAS unsigned*)(F.lds + MISC_OFF);
    F.wave = __builtin_amdgcn_readfirstlane((int)threadIdx.x >> 6); F.lane = (int)__builtin_amdgcn_mbcnt_hi(~0u, __builtin_amdgcn_mbcnt_lo(~0u, 0u)); F.tid = F.wave * 64 + F.lane;
    F.G = gridDim.x; { const int bx = blockIdx.x; F.vcu = (F.G % 8 == 0) ? (bx % 8) * (F.G / 8) + bx / 8 : bx; }
    for (int u = F.tid; u < (LDS_BYTES - LDSCTL_OFF) / 4; u += NTHREADS) ((LAS unsigned*)(F.lds + LDSCTL_OFF))[u] = 0u;
    __syncthreads();
    if (F.tid == 0) {
        LAS unsigned long long* tb = (LAS unsigned long long*)(F.lds + TBL_OFF);
#pragma unroll
        for (int k = 0; k < 28; ++k) tb[k] = (unsigned long long)args.in[k];
        tb[28] = (unsigned long long)args.out; tb[29] = (unsigned long long)args.ws;
    }
    const int lo = args.ph_lo, hi = args.ph_hi;
    __syncthreads();
    XcdBarrier bar; bar.bar = (unsigned*)(WSP + WS_CTL) + CW_BAR; bar.x = 0; bar.st = nullptr;
    const bool one_launch = (hi - lo) > 1;
    if (one_launch) bar = xcd_barrier_post(bar.bar, F.MISC + 8);
#ifndef PHASE_MASK
#define PHASE_MASK 0xFFFFu
#endif
#define IN(k) ((((PHASE_MASK) >> (k)) & 1u) && lo <= (k) && (k) < hi)
#define SEAM(k) do { if (IN(k) && IN((k) + 1)) xcd_barrier(bar); } while (0)
    const int bx = (int)blockIdx.x;
    volatile LAS int* ts = (volatile LAS int*)(F.MISC + 16);

#ifndef REPEAT_MASK
#define REPEAT_MASK 0u
#endif
#define PH(k, ...) do { if (IN(k)) { { __VA_ARGS__ } if (((REPEAT_MASK) >> (k)) & 1u) { if (one_launch) xcd_barrier(bar); { __VA_ARGS__ } } } SEAM(k); } while (0)
#ifndef BAR_EXTRA
#define BAR_EXTRA 0
#endif
    PH(0, p0_prologue(F););
    if (one_launch) for (int _b = 0; _b < BAR_EXTRA; ++_b) xcd_barrier(bar);
    PH(2, unsigned char* ws = WSP; SchedP1 S{(const char*)(ws + WS_XN), (const char*)(ws + WS_WIN), (const char*)(ws + WS_WB), (const char*)(ws + WS_WPS), F.G, bx};
        EpiP1 E{EpiZ{(bf16*)(ws + WS_Z)}, EpiPlain{(bf16*)(ws + WS_W2), 1024}}; g8::gemm_phase<false>(F.lds, F.wave, S, E););
    PH(3, p2_fast(F););
    PH(5, unsigned char* ws = WSP; SchedU S{(const char*)(ws + WS_YD), (const char*)(ws + WS_WA), (const char*)(ws + WS_W2), F.G, bx}; EpiU E{(bf16*)(ws + WS_XN), (const bf16*)(ws + WS_Z)}; g8::gemm_phase<false>(F.lds, F.wave, S, E););
    PH(6, unsigned char* ws = WSP; SchedDense S{(const char*)(ws + WS_XN), (const char*)(ws + WS_WOUT), 4096, 4096, 32, 32, 8, F.G, bx}; EpiX1 E{INP(0), (bf16*)(ws + WS_YD)}; g8::gemm_phase<false>(F.lds, F.wave, S, E););
    PH(7, p5_fast(F););
    PH(8, moe_table(F, ts); unsigned char* ws = WSP;
        SchedMoe S; S.wsb = (const char*)ws; S.ts = ts; S.init(F.G, F.vcu, __builtin_amdgcn_readfirstlane(ts[16]));
        EpiMoe E{ws};
        g8::gemm_phase<true>(F.lds, F.wave, S, E););
    PH(10, p8_combine(F););
    if (F.G == 256) {
        PH(11, unsigned char* ws = WSP;
            SchedDense S{(const char*)(ws + WS_YD), (const char*)(ws + WS_WPG), 4096, 4096, 32, 32, 8, F.G, bx};
            EpiPleF E{OUTP, (const bf16*)(ws + WS_YD), (const bf16*)(ws + WS_XN), (const float*)(ws + WS_MISC + MI_RSTDP), INP(27), (float*)(ws + WS_MISC + MI_XS), (unsigned*)(ws + WS_CTL) + CW_PAN};
            g8::gemm_phase<false>(F.lds, F.wave, S, E););
    } else {
        PH(11, unsigned char* ws = WSP;
            SchedDense S{(const char*)(ws + WS_YD), (const char*)(ws + WS_WPG), 4096, 4096, 32, 32, 8, F.G, bx};
            EpiPle E{OUTP, (const bf16*)(ws + WS_YD), (const bf16*)(ws + WS_XN), (const float*)(ws + WS_MISC + MI_RSTDP)}; g8::gemm_phase<false>(F.lds, F.wave, S, E););
        PH(12, p10_final(F););
    }
#undef PH
#undef IN
#undef SEAM
}

extern "C" void kernel_launch(void* const* d_in, const int* in_sizes, int n_in, void* d_out, int out_size, void* d_ws, size_t ws_size, hipStream_t stream) {
    static int grid = 0;
    if (grid == 0) {
        if (n_in != 28 || in_sizes[0] != T * D || out_size != T * D || ws_size < WS_END) { fprintf(stderr, "kernel_launch: unexpected shapes / workspace (n_in %d, ws %zu < %zu)\n", n_in, ws_size, (size_t)WS_END); grid = -1; return; }
        int dev = 0, cus = 0, per_cu = 0;
        if (hipGetDevice(&dev) != hipSuccess || hipDeviceGetAttribute(&cus, hipDeviceAttributeMultiprocessorCount, dev) != hipSuccess) { grid = -1; return; }
        if (hipFuncSetAttribute((const void*)mk_fwd, hipFuncAttributeMaxDynamicSharedMemorySize, LDS_BYTES) != hipSuccess) { fprintf(stderr, "kernel_launch: hipFuncSetAttribute failed\n"); grid = -1; return; }
        if (hipOccupancyMaxActiveBlocksPerMultiprocessor(&per_cu, (const void*)mk_fwd, NTHREADS, LDS_BYTES) != hipSuccess || per_cu < 1) { fprintf(stderr, "kernel_launch: occupancy query says %d blocks/CU\n", per_cu); (void)hipGetLastError(); grid = -1; return; }
        grid = cus;
    }
    if (grid < 0) return;
    (void)hipMemsetAsync((char*)d_ws + WS_CTL, 0, CTL_ZERO_BYTES, stream);
    Args a{};
    for (int i = 0; i < 28; ++i) a.in[i] = (const float*)d_in[i];
    a.out = (float*)d_out; a.ws = (unsigned char*)d_ws;
#if MK_N_LAUNCHES == 1
    a.ph_lo = 0; a.ph_hi = N_PHASES;
    hipLaunchKernelGGL(mk_fwd, dim3(grid), dim3(NTHREADS), LDS_BYTES, stream, a);
#else
    for (int p = 0; p < N_PHASES; ++p) { a.ph_lo = p; a.ph_hi = p + 1; hipLaunchKernelGGL(mk_fwd, dim3(grid), dim3(NTHREADS), LDS_BYTES, stream, a); }
#endif
}
```
